# Optimizing an MI355X kernel written in HIP

```python
import jax, jax.numpy as jnp
from jax import lax
import numpy as np

D_MODEL = 1024
BATCH = 2
SEQ = 16384
DEPTH = 2

GRID_W = 64
CTX_LEN = 256
EPS = 1e-6
ROPE_BASE = 10000.0
NEG_INF = -1e30

GLA_HEADS = 4
GLA_HEAD_K = D_MODEL // (2 * GLA_HEADS)
GLA_HEAD_V = D_MODEL // GLA_HEADS
GLA_QK = GLA_HEADS * GLA_HEAD_K
GLA_V = GLA_HEADS * GLA_HEAD_V
GLA_RANK = 16
GLA_GATE_NORM = 16.0
GLA_CHUNK = 64

SWA_HEADS = 8
SWA_KV_HEADS = 2
SWA_GROUP = SWA_HEADS // SWA_KV_HEADS
SWA_HEAD_DIM = D_MODEL // SWA_HEADS
SWA_WINDOW = 128
SWA_BLOCK = 128
SWA_SCALE = SWA_HEAD_DIM ** -0.5

MLA_HEADS = 8
MLA_Q_RANK = 384
MLA_KV_RANK = 256
MLA_NOPE = 128
MLA_ROPE = 64
MLA_V = D_MODEL // MLA_HEADS
MLA_QUERY_BLOCK = 128
MLA_SCALE = (MLA_NOPE + MLA_ROPE) ** -0.5

N_BRANCH = 3
BRANCH_W = D_MODEL
FF_DIM = 4 * D_MODEL

IN_SIZES = (GLA_QK, GLA_QK, GLA_V, GLA_V, GLA_RANK, GLA_RANK,
            SWA_HEADS * SWA_HEAD_DIM, SWA_KV_HEADS * SWA_HEAD_DIM, SWA_KV_HEADS * SWA_HEAD_DIM,
            MLA_Q_RANK, MLA_KV_RANK, MLA_ROPE, N_BRANCH * D_MODEL)
IN_WIDTH = sum(IN_SIZES)
IN_OFFSETS = tuple(int(v) for v in np.cumsum(IN_SIZES)[:-1])

kernel_name = 'hybrid_gla_swa_mla_prefix_dit'


def rms_norm(x, w):
    xf = x.astype(jnp.float32)
    y = xf * lax.rsqrt(jnp.mean(xf * xf, axis=-1, keepdims=True) + EPS)
    return (y * w.astype(jnp.float32)).astype(x.dtype)


def modulate(x, w, shift, scale):
    return rms_norm(x, w) * (1 + scale[..., None, :]) + shift[..., None, :]


def squared_relu_mlp(h, w1, w2):
    return jnp.square(jax.nn.relu(h @ w1)) @ w2


def axial_tables(row, col, dim, dtype):
    d_axis = dim // 2
    inv = ROPE_BASE ** (-jnp.arange(0, d_axis, 2, dtype=jnp.float32) / d_axis)
    ang_r = row.astype(jnp.float32)[:, None] * inv
    ang_c = col.astype(jnp.float32)[:, None] * inv
    return tuple(t[:, None, :].astype(dtype) for t in (jnp.cos(ang_r), jnp.sin(ang_r), jnp.cos(ang_c), jnp.sin(ang_c)))


def rope_rotate(x, cos, sin):
    x1, x2 = jnp.split(x, 2, axis=-1)
    return jnp.concatenate([x1 * cos - x2 * sin, x2 * cos + x1 * sin], axis=-1)


def apply_axial(x, tabs):
    cos_r, sin_r, cos_c, sin_c = tabs
    x_row, x_col = jnp.split(x, 2, axis=-1)
    return jnp.concatenate([rope_rotate(x_row, cos_r, sin_r), rope_rotate(x_col, cos_c, sin_c)], axis=-1)


def to_heads(t, n_heads):
    b, t_len, _ = t.shape
    return t.reshape(b, t_len, n_heads, -1).transpose(0, 2, 1, 3)


def from_heads(t):
    b, h, t_len, d = t.shape
    return t.transpose(0, 2, 1, 3).reshape(b, t_len, h * d)


def gla_log_decay(z, a_w, a_b):
    return jax.nn.log_sigmoid((z @ a_w + a_b).astype(jnp.float32)) / GLA_GATE_NORM


def gla_chunked(q, k, v, log_a, s0):
    b_, h_, t_len, dk = q.shape
    dv = v.shape[-1]
    n = t_len // GLA_CHUNK
    f32 = jnp.float32
    qc = q.astype(f32).reshape(b_, h_, n, GLA_CHUNK, dk)
    kc = k.astype(f32).reshape(b_, h_, n, GLA_CHUNK, dk)
    vc = v.astype(f32).reshape(b_, h_, n, GLA_CHUNK, dv)
    bcum = jnp.cumsum(log_a.astype(f32).reshape(b_, h_, n, GLA_CHUNK, dk), axis=3)
    b_last = bcum[:, :, :, -1:, :]
    q_dec = qc * jnp.exp(bcum)
    k_inv = kc * jnp.exp(-bcum)
    k_end = kc * jnp.exp(b_last - bcum)
    causal = jnp.tril(jnp.ones((GLA_CHUNK, GLA_CHUNK), bool))
    a_intra = jnp.where(causal, jnp.einsum('bhnid,bhnjd->bhnij', q_dec, k_inv), 0.0)
    o_intra = jnp.einsum('bhnij,bhnjv->bhniv', a_intra, vc)
    u = jnp.einsum('bhncd,bhncv->bhndv', k_end, vc)
    g = jnp.exp(b_last[:, :, :, 0, :])

    def step(s, inp):
        g_n, u_n = inp
        return g_n[..., None] * s + u_n, s

    s_final, s_prev = lax.scan(step, s0, (jnp.moveaxis(g, 2, 0), jnp.moveaxis(u, 2, 0)))
    o_inter = jnp.einsum('bhncd,nbhdv->bhncv', q_dec, s_prev)
    o = (o_intra + o_inter).reshape(b_, h_, t_len, dv).astype(v.dtype)
    return o, s_final


def gla_bidirectional(q, k, v, la_f, la_b, s0_f, s0_b):
    o_f, s_f = gla_chunked(q, k, v, la_f, s0_f)
    flip = lambda t: jnp.flip(t, axis=2)
    o_b, s_b = gla_chunked(flip(q), flip(k), flip(v), flip(la_b), s0_b)
    return o_f + flip(o_b), s_f, s_b


def gla_output(o, r, norm_w):
    return from_heads(rms_norm(o, norm_w)) * jax.nn.silu(r)


def swa_latent(q, k, v, k_ctx, v_ctx, sink):
    b_, t_len = q.shape[0], q.shape[1]
    nb = t_len // SWA_BLOCK
    qb = q.reshape(b_, nb, SWA_BLOCK, SWA_KV_HEADS, SWA_GROUP, SWA_HEAD_DIM)

    def band(t):
        pad = jnp.zeros((b_, SWA_BLOCK) + t.shape[2:], t.dtype)
        tp = jnp.concatenate([pad, t, pad], axis=1).reshape((b_, nb + 2, SWA_BLOCK) + t.shape[2:])
        return jnp.concatenate([tp[:, :-2], tp[:, 1:-1], tp[:, 2:]], axis=2)

    kb, vb = band(k), band(v)
    blk = jnp.arange(nb)[:, None, None]
    q_pos = blk * SWA_BLOCK + jnp.arange(SWA_BLOCK)[None, :, None]
    k_pos = (blk - 1) * SWA_BLOCK + jnp.arange(3 * SWA_BLOCK)[None, None, :]
    valid = (jnp.abs(q_pos - k_pos) <= SWA_WINDOW) & (k_pos >= 0) & (k_pos < t_len)
    s_loc = jnp.einsum('bnqkgd,bnskd->bkgnqs', qb, kb, preferred_element_type=jnp.float32) * SWA_SCALE
    s_loc = jnp.where(valid, s_loc, NEG_INF)
    s_ctx = jnp.einsum('bnqkgd,bskd->bkgnqs', qb, k_ctx, preferred_element_type=jnp.float32) * SWA_SCALE
    sink_col = jnp.broadcast_to(sink.astype(jnp.float32).reshape(1, SWA_KV_HEADS, SWA_GROUP, 1, 1, 1),
                                s_loc.shape[:-1] + (1,))
    p = jax.nn.softmax(jnp.concatenate([s_loc, s_ctx, sink_col], axis=-1), axis=-1).astype(v.dtype)
    n_loc = 3 * SWA_BLOCK
    o = (jnp.einsum('bkgnqs,bnskd->bnqkgd', p[..., :n_loc], vb)
         + jnp.einsum('bkgnqs,bskd->bnqkgd', p[..., n_loc:n_loc + k_ctx.shape[1]], v_ctx))
    return o.reshape(b_, t_len, SWA_HEADS * SWA_HEAD_DIM)


def swa_context(q, k, v, sink):
    b_, l_c = q.shape[0], q.shape[1]
    qg = q.reshape(b_, l_c, SWA_KV_HEADS, SWA_GROUP, SWA_HEAD_DIM)
    s = jnp.einsum('bqkgd,bskd->bkgqs', qg, k, preferred_element_type=jnp.float32) * SWA_SCALE
    sink_col = jnp.broadcast_to(sink.astype(jnp.float32).reshape(1, SWA_KV_HEADS, SWA_GROUP, 1, 1),
                                s.shape[:-1] + (1,))
    p = jax.nn.softmax(jnp.concatenate([s, sink_col], axis=-1), axis=-1).astype(v.dtype)
    o = jnp.einsum('bkgqs,bskd->bqkgd', p[..., :l_c], v)
    return o.reshape(b_, l_c, SWA_HEADS * SWA_HEAD_DIM)


def mla_keys(c_kv, k_rope, norm_w, w_ukv, rope):
    b_, t_len, _ = c_kv.shape
    kv = (rms_norm(c_kv, norm_w) @ w_ukv).reshape(b_, t_len, MLA_HEADS, MLA_NOPE + MLA_V)
    k_nope, v = jnp.split(kv, [MLA_NOPE], axis=-1)
    k_pe = k_rope[:, :, None, :]
    if rope is not None:
        k_pe = apply_axial(k_pe, rope)
    k = jnp.concatenate([k_nope, jnp.broadcast_to(k_pe, (b_, t_len, MLA_HEADS, MLA_ROPE))], axis=-1)
    return k, v


def mla_queries(c_q, norm_w, w_uq, rope):
    b_, t_len, _ = c_q.shape
    q = (rms_norm(c_q, norm_w) @ w_uq).reshape(b_, t_len, MLA_HEADS, MLA_NOPE + MLA_ROPE)
    if rope is not None:
        q_nope, q_pe = jnp.split(q, [MLA_NOPE], axis=-1)
        q = jnp.concatenate([q_nope, apply_axial(q_pe, rope)], axis=-1)
    return q


def dense_attention(q, k, v, scale):
    b_, t_len, h_, dq = q.shape
    nb = t_len // MLA_QUERY_BLOCK
    qb = q.reshape(b_, nb, MLA_QUERY_BLOCK, h_, dq).transpose(1, 0, 2, 3, 4)

    def attend_block(q_blk):
        s = jnp.einsum('bqhd,bshd->bhqs', q_blk, k, preferred_element_type=jnp.float32) * scale
        p = jax.nn.softmax(s, axis=-1).astype(v.dtype)
        return jnp.einsum('bhqs,bshv->bqhv', p, v)

    o = lax.map(attend_block, qb)
    return o.transpose(1, 0, 2, 3, 4).reshape(b_, t_len, h_ * v.shape[-1])


def merge_branches(gates, o_gla, o_swa, o_mla, w_branch, w_out):
    g = jax.nn.sigmoid(gates.reshape(gates.shape[:-1] + (N_BRANCH, D_MODEL)))
    merged = (g[..., 0, :] * (o_gla @ w_branch[0])
              + g[..., 1, :] * (o_swa @ w_branch[1])
              + g[..., 2, :] * (o_mla @ w_branch[2]))
    return merged @ w_out


def token_mixers(h, hc, w_in, gla_a_w, gla_a_b, gla_norm_w, swa_sink, mla_q_norm_w, mla_w_uq,
                 mla_kv_norm_w, mla_w_ukv, w_branch, w_out, rope_swa, rope_mla, with_ctx_out):
    b_, t_len, _ = h.shape
    l_c = hc.shape[1]
    (gq, gk, gv, gr, gzf, gzb, sq, sk, sv, mcq, mckv, mkr, gates) = jnp.split(h @ w_in, IN_OFFSETS, axis=-1)
    (cgq, cgk, cgv, cgr, cgzf, cgzb, csq, csk, csv, cmcq, cmckv, cmkr, cgates) = jnp.split(hc @ w_in, IN_OFFSETS, axis=-1)

    def gla_inputs(q, k, v, zf, zb):
        return (to_heads(q * GLA_HEAD_K ** -0.5, GLA_HEADS), to_heads(k, GLA_HEADS), to_heads(v, GLA_HEADS),
                to_heads(gla_log_decay(zf, gla_a_w[0], gla_a_b[0]), GLA_HEADS),
                to_heads(gla_log_decay(zb, gla_a_w[1], gla_a_b[1]), GLA_HEADS))

    s0 = jnp.zeros((b_, GLA_HEADS, GLA_HEAD_K, GLA_HEAD_V), jnp.float32)
    o_gc, s_f, s_b = gla_bidirectional(*gla_inputs(cgq, cgk, cgv, cgzf, cgzb), s0, s0)
    o_g, _, _ = gla_bidirectional(*gla_inputs(gq, gk, gv, gzf, gzb), s_f, s_b)
    o_gla = gla_output(o_g, gr, gla_norm_w)

    q_s = apply_axial(sq.reshape(b_, t_len, SWA_HEADS, SWA_HEAD_DIM), rope_swa)
    k_s = apply_axial(sk.reshape(b_, t_len, SWA_KV_HEADS, SWA_HEAD_DIM), rope_swa)
    v_s = sv.reshape(b_, t_len, SWA_KV_HEADS, SWA_HEAD_DIM)
    k_sc = csk.reshape(b_, l_c, SWA_KV_HEADS, SWA_HEAD_DIM)
    v_sc = csv.reshape(b_, l_c, SWA_KV_HEADS, SWA_HEAD_DIM)
    o_swa = swa_latent(q_s, k_s, v_s, k_sc, v_sc, swa_sink)

    k_m, v_m = mla_keys(mckv, mkr, mla_kv_norm_w, mla_w_ukv, rope_mla)
    k_mc, v_mc = mla_keys(cmckv, cmkr, mla_kv_norm_w, mla_w_ukv, None)
    q_m = mla_queries(mcq, mla_q_norm_w, mla_w_uq, rope_mla)
    o_mla = dense_attention(q_m, jnp.concatenate([k_m, k_mc], axis=1), jnp.concatenate([v_m, v_mc], axis=1), MLA_SCALE)

    y = merge_branches(gates, o_gla, o_swa, o_mla, w_branch, w_out)
    if not with_ctx_out:
        return y, None

    o_gla_c = gla_output(o_gc, cgr, gla_norm_w)
    o_swa_c = swa_context(csq.reshape(b_, l_c, SWA_HEADS, SWA_HEAD_DIM), k_sc, v_sc, swa_sink)
    o_mla_c = dense_attention(mla_queries(cmcq, mla_q_norm_w, mla_w_uq, None), k_mc, v_mc, MLA_SCALE)
    yc = merge_branches(cgates, o_gla_c, o_swa_c, o_mla_c, w_branch, w_out)
    return y, yc


def setup_inputs(seed: int = 0) -> dict:
    key = jax.random.key(seed)
    ks = jax.random.split(key, 22)
    f32 = jnp.float32

    def dense(k, shape, fan_in):
        return jax.random.normal(k, shape, f32) * fan_in ** -0.5

    def gain(k, shape):
        return 1.0 + 0.02 * jax.random.normal(k, shape, f32)

    return {
        'x': jax.random.normal(ks[0], (BATCH, SEQ, D_MODEL), f32),
        'c': jax.random.normal(ks[1], (BATCH, D_MODEL), f32),
        'ctx': jax.random.normal(ks[2], (BATCH, CTX_LEN, D_MODEL), f32),
        'c_ctx': jax.random.normal(ks[3], (D_MODEL,), f32),
        'ada_w': dense(ks[4], (DEPTH, D_MODEL, 6 * D_MODEL), D_MODEL),
        'ada_b': 0.02 * jax.random.normal(ks[5], (DEPTH, 6 * D_MODEL), f32),
        'norm_mix_w': gain(ks[6], (DEPTH, D_MODEL)),
        'w_in': dense(ks[7], (DEPTH, D_MODEL, IN_WIDTH), D_MODEL),
        'gla_a_w': dense(ks[8], (DEPTH, 2, GLA_RANK, GLA_QK), GLA_RANK),
        'gla_a_b': 0.1 * jax.random.normal(ks[9], (DEPTH, 2, GLA_QK), f32),
        'gla_norm_w': gain(ks[10], (DEPTH, GLA_HEAD_V)),
        'swa_sink': 0.5 * jax.random.normal(ks[11], (DEPTH, SWA_HEADS), f32),
        'mla_q_norm_w': gain(ks[12], (DEPTH, MLA_Q_RANK)),
        'mla_w_uq': dense(ks[13], (DEPTH, MLA_Q_RANK, MLA_HEADS * (MLA_NOPE + MLA_ROPE)), MLA_Q_RANK),
        'mla_kv_norm_w': gain(ks[14], (DEPTH, MLA_KV_RANK)),
        'mla_w_ukv': dense(ks[15], (DEPTH, MLA_KV_RANK, MLA_HEADS * (MLA_NOPE + MLA_V)), MLA_KV_RANK),
        'w_branch': dense(ks[16], (DEPTH, N_BRANCH, BRANCH_W, D_MODEL), BRANCH_W),
        'w_out': dense(ks[17], (DEPTH, D_MODEL, D_MODEL), D_MODEL),
        'norm_mlp_w': gain(ks[18], (DEPTH, D_MODEL)),
        'mlp_w1': dense(ks[19], (DEPTH, D_MODEL, FF_DIM), D_MODEL),
        'mlp_w2': dense(ks[20], (DEPTH, FF_DIM, D_MODEL), FF_DIM),
        'final_norm_w': gain(ks[21], (D_MODEL,)),
    }


def reference(x, c, ctx, c_ctx, ada_w, ada_b, norm_mix_w, w_in, gla_a_w, gla_a_b, gla_norm_w, swa_sink,
              mla_q_norm_w, mla_w_uq, mla_kv_norm_w, mla_w_ukv, w_branch, w_out, norm_mlp_w, mlp_w1, mlp_w2,
              final_norm_w):
    n_tok = x.shape[1]
    rows = n_tok // GRID_W
    row = jnp.repeat(jnp.arange(rows), GRID_W)
    col = jnp.tile(jnp.arange(GRID_W), rows)
    rope_swa = axial_tables(row, col, SWA_HEAD_DIM, x.dtype)
    rope_mla = axial_tables(row, col, MLA_ROPE, x.dtype)
    xc = ctx
    for layer in range(DEPTH):
        with_ctx_out = layer < DEPTH - 1
        mod = jax.nn.silu(c) @ ada_w[layer] + ada_b[layer]
        mod_c = jax.nn.silu(c_ctx) @ ada_w[layer] + ada_b[layer]
        sh_m, sc_m, g_m, sh_f, sc_f, g_f = jnp.split(mod, 6, axis=-1)
        csh_m, csc_m, cg_m, csh_f, csc_f, cg_f = jnp.split(mod_c, 6, axis=-1)
        y, yc = token_mixers(modulate(x, norm_mix_w[layer], sh_m, sc_m),
                             modulate(xc, norm_mix_w[layer], csh_m, csc_m),
                             w_in[layer], gla_a_w[layer], gla_a_b[layer], gla_norm_w[layer], swa_sink[layer],
                             mla_q_norm_w[layer], mla_w_uq[layer], mla_kv_norm_w[layer], mla_w_ukv[layer],
                             w_branch[layer], w_out[layer], rope_swa, rope_mla, with_ctx_out)
        x = x + g_m[:, None, :] * y
        x = x + g_f[:, None, :] * squared_relu_mlp(modulate(x, norm_mlp_w[layer], sh_f, sc_f),
                                                   mlp_w1[layer], mlp_w2[layer])
        if with_ctx_out:
            xc = xc + cg_m * yc
            xc = xc + cg_f * squared_relu_mlp(modulate(xc, norm_mlp_w[layer], csh_f, csc_f),
                                              mlp_w1[layer], mlp_w2[layer])
    return rms_norm(x, final_norm_w)
```

```cpp
#include <hip/hip_runtime.h>
#include <hip/hip_cooperative_groups.h>
#include <cstdio>
#include <cstdint>
namespace cg = cooperative_groups;

typedef unsigned short bf16_t;
using bf16x8 = __attribute__((ext_vector_type(8))) short;
using s16x4  = __attribute__((ext_vector_type(4))) short;
using f32x4  = __attribute__((ext_vector_type(4))) float;
using f32x16 = __attribute__((ext_vector_type(16))) float;
using u32x4  = __attribute__((ext_vector_type(4))) unsigned;
using u32x2  = __attribute__((ext_vector_type(2))) unsigned;
#define DI __device__ __forceinline__
#define SBAR() __builtin_amdgcn_sched_barrier(0)
__device__ __forceinline__ int tid_opaque() { int t = threadIdx.x; asm volatile("" : "+v"(t)); return t; }

constexpr int DM = 1024, NB = 2, SEQ = 16384, CTX = 256, DEPTH = 2;
constexpr int TB = SEQ + CTX;
constexpr int TALL = NB * TB;
constexpr int NLAT = NB * SEQ;
constexpr int INW = 8416;
constexpr int NIN = 5376;
constexpr float EPS = 1e-6f;
constexpr float LOG2E = 1.4426950408889634f;

constexpr long W_IN = 0;
constexpr long W_G  = W_IN + (long)NIN * 1024;
constexpr long W_UQ = W_G + 3072L * 1024;
constexpr long W_UKV = W_UQ + 1536L * 384;
constexpr long W_B  = W_UKV + 2048L * 256;
constexpr long W_O  = W_B + 3L * 1024 * 1024;
constexpr long W_1  = W_O + 1024L * 1024;
constexpr long W_2  = W_1 + 4096L * 1024;
constexpr long W_LAYER = W_2 + 1024L * 4096;

constexpr size_t al256(size_t x) { return (x + 255) / 256 * 256; }
constexpr size_t O_W    = 0;
constexpr size_t O_MOD  = al256(O_W + (size_t)DEPTH * W_LAYER * 2);
constexpr size_t O_RSWA = al256(O_MOD + (size_t)DEPTH * 3 * 6144 * 4);
constexpr size_t O_RMLA = al256(O_RSWA + 256 * 32 * 8);
constexpr size_t O_BAR  = al256(O_RMLA + 256 * 16 * 8);
constexpr size_t O_GT   = al256(O_BAR + 1024);
constexpr size_t O_XC   = al256(O_GT + 2 * 260 * 512 * 4);
constexpr size_t O_H    = al256(O_XC + (size_t)NB * CTX * DM * 4);
constexpr size_t O_M    = al256(O_H + (size_t)TALL * DM * 2);
constexpr size_t O_R1   = O_M;
constexpr size_t O_R2   = al256(O_R1 + (size_t)TB * 2048 * 2);
constexpr size_t O_PR   = al256(O_R2 + (size_t)TB * 1536 * 2);
constexpr size_t O_PZ   = al256(O_PR + (size_t)TB * 1024 * 2);
constexpr size_t O_PM   = al256(O_PZ + (size_t)TB * 32 * 2);
constexpr size_t O_KM   = al256(O_PM + (size_t)TB * 704 * 2);
constexpr size_t O_VM   = al256(O_KM + (size_t)TB * 1536 * 2);
constexpr size_t O_OF   = al256(O_VM + (size_t)TB * 1024 * 2);
constexpr size_t O_OB   = al256(O_OF + (size_t)TB * 1024 * 2);
constexpr size_t O_OSW  = al256(O_OB + (size_t)TB * 1024 * 2);
constexpr size_t O_END  = al256(O_OSW + (size_t)TB * 1024 * 2);
constexpr size_t O_SE   = O_END;
constexpr size_t O_GTOT = al256(O_SE + 512ull * 4096 * 4);
constexpr size_t O_END2 = al256(O_GTOT + 512ull * 128 * 4);
constexpr size_t O_U    = O_M;
static_assert(O_U + (size_t)TALL * 4096 * 2 <= O_END, "U must fit in mixer region");

constexpr int LDS_BYTES = 65536;

struct Params {
  const float *x, *c, *ctx, *c_ctx, *ada_w, *ada_b, *norm_mix_w, *w_in, *gla_a_w, *gla_a_b, *gla_norm_w, *swa_sink,
      *mla_q_norm_w, *mla_w_uq, *mla_kv_norm_w, *mla_w_ukv, *w_branch, *w_out, *norm_mlp_w, *mlp_w1, *mlp_w2, *final_norm_w;
  float* out;
  char* ws;
};

typedef __bf16 bf16x2_t __attribute__((ext_vector_type(2)));
typedef float float2_t __attribute__((ext_vector_type(2)));
DI unsigned cvtpk(float lo, float hi) { float2_t f = {lo, hi}; bf16x2_t r = __builtin_convertvector(f, bf16x2_t); return __builtin_bit_cast(unsigned, r); }
DI bf16_t f2bf(float x) { return (bf16_t)(cvtpk(x, x) & 0xffffu); }
DI float bf2f(bf16_t v) { return __uint_as_float(((unsigned)v) << 16); }
DI float bflo(unsigned u) { return __uint_as_float(u << 16); }
DI float bfhi(unsigned u) { return __uint_as_float(u & 0xffff0000u); }
DI float wave_sum(float v) {
  v += __shfl_xor(v, 32); v += __shfl_xor(v, 16); v += __shfl_xor(v, 8); v += __shfl_xor(v, 4); v += __shfl_xor(v, 2); v += __shfl_xor(v, 1);
  return v;
}
DI int crow(int r, int hi) { return (r & 3) + 8 * (r >> 2) + 4 * hi; }
DI float sigmoidf_(float x) { return 1.f / (1.f + __expf(-x)); }
DI long grow_of(int b, int lr) { return lr < SEQ ? (long)b * SEQ + lr : (long)NLAT + b * CTX + (lr - SEQ); }
#define MFMA16(a, b, c) __builtin_amdgcn_mfma_f32_16x16x32_bf16((a), (b), (c), 0, 0, 0)
#define MFMA32(a, b, c) __builtin_amdgcn_mfma_f32_32x32x16_bf16((a), (b), (c), 0, 0, 0)

DI void conv_tile(const float* __restrict__ src, int ld_src, bf16_t* __restrict__ dst, int K, int n0, int k0, int kind,
                  const float* __restrict__ kscale, float* lds) {
  const int tid = tid_opaque();
  {
    const int nn = tid & 63; const int n = n0 + nn;
    int sc = n; float s = 1.f;
    if (kind == 1) {
      if (n < 3072) { sc = n; s = (n < 512) ? 0.08838834764831845f : 1.f; }
      else if (n < 5312) sc = n + 32;
      else if (n < 5344) sc = n - 5312 + 3072;
      else sc = -1;
    } else if (kind == 2) sc = 5344 + n;
#pragma unroll
    for (int i = 0; i < 16; ++i) {
      const int kk = (tid >> 6) + 4 * i;
      float v = 0.f;
      if (sc >= 0) { v = src[(long)(k0 + kk) * ld_src + sc] * s; if (kscale) v *= kscale[k0 + kk]; }
      lds[kk * 65 + nn] = v;
    }
  }
  __syncthreads();
  {
    const int kk2 = (tid & 31) * 2;
#pragma unroll
    for (int i = 0; i < 8; ++i) {
      const int n = (tid >> 5) + 8 * i;
      const float a = lds[kk2 * 65 + n], b = lds[(kk2 + 1) * 65 + n];
      *(unsigned*)&dst[(long)(n0 + n) * K + k0 + kk2] = cvtpk(a, b);
    }
  }
  __syncthreads();
}

constexpr int CONV_PER_LAYER = 1344 + 768 + 144 + 128 + 768 + 256 + 1024 + 1024;
DI void conv_item(const Params& p, int it, char* lds) {
  const int l = it / CONV_PER_LAYER; int t = it % CONV_PER_LAYER;
  bf16_t* W = (bf16_t*)(p.ws + O_W) + (long)l * W_LAYER;
  float* f = (float*)lds;
  if (t < 1344) { conv_tile(p.w_in + (long)l * 1024 * INW, INW, W + W_IN, 1024, (t / 16) * 64, (t % 16) * 64, 1, nullptr, f); return; }
  t -= 1344;
  if (t < 768) { conv_tile(p.w_in + (long)l * 1024 * INW, INW, W + W_G, 1024, (t / 16) * 64, (t % 16) * 64, 2, nullptr, f); return; }
  t -= 768;
  if (t < 144) { conv_tile(p.mla_w_uq + (long)l * 384 * 1536, 1536, W + W_UQ, 384, (t / 6) * 64, (t % 6) * 64, 0, p.mla_q_norm_w + l * 384, f); return; }
  t -= 144;
  if (t < 128) { conv_tile(p.mla_w_ukv + (long)l * 256 * 2048, 2048, W + W_UKV, 256, (t / 4) * 64, (t % 4) * 64, 0, p.mla_kv_norm_w + l * 256, f); return; }
  t -= 128;
  if (t < 768) { const int i = t / 256, tt = t % 256;
    conv_tile(p.w_branch + ((long)l * 3 + i) * 1024 * 1024, 1024, W + W_B + (long)i * 1024 * 1024, 1024, (tt / 16) * 64, (tt % 16) * 64, 0, nullptr, f); return; }
  t -= 768;
  if (t < 256) { conv_tile(p.w_out + (long)l * 1024 * 1024, 1024, W + W_O, 1024, (t / 16) * 64, (t % 16) * 64, 0, nullptr, f); return; }
  t -= 256;
  if (t < 1024) { conv_tile(p.mlp_w1 + (long)l * 1024 * 4096, 4096, W + W_1, 1024, (t / 16) * 64, (t % 16) * 64, 0, nullptr, f); return; }
  t -= 1024;
  conv_tile(p.mlp_w2 + (long)l * 4096 * 1024, 1024, W + W_2, 4096, (t / 64) * 64, (t % 64) * 64, 0, nullptr, f);
}

DI void adaln_item(const Params& p, int it, char* lds) {
  const int l = it / 96, cb = it % 96, tid = tid_opaque();
  float* sv = (float*)lds;
  float* red = sv + 3072;
  for (int i = tid; i < 3072; i += 256) {
    const int v = i >> 10, k = i & 1023;
    const float x = (v < 2) ? p.c[v * 1024 + k] : p.c_ctx[k];
    sv[i] = x / (1.f + __expf(-x));
  }
  __syncthreads();
  const int col = tid & 63, kq = tid >> 6;
  const float* w = p.ada_w + (long)l * 1024 * 6144 + cb * 64 + col;
  float a0 = 0, a1 = 0, a2 = 0;
#pragma unroll 8
  for (int k = kq * 256; k < kq * 256 + 256; ++k) {
    const float wv = w[(long)k * 6144];
    a0 += sv[k] * wv; a1 += sv[1024 + k] * wv; a2 += sv[2048 + k] * wv;
  }
  red[(kq * 3 + 0) * 64 + col] = a0; red[(kq * 3 + 1) * 64 + col] = a1; red[(kq * 3 + 2) * 64 + col] = a2;
  __syncthreads();
  if (tid < 192) {
    const int v = tid >> 6, cc = tid & 63;
    const float s = red[(0 * 3 + v) * 64 + cc] + red[(1 * 3 + v) * 64 + cc] + red[(2 * 3 + v) * 64 + cc] + red[(3 * 3 + v) * 64 + cc];
    float* mod = (float*)(p.ws + O_MOD);
    mod[((long)l * 3 + v) * 6144 + cb * 64 + cc] = s + p.ada_b[l * 6144 + cb * 64 + cc];
  }
  __syncthreads();
}

DI void rope_item(const Params& p) {
  const int pos = tid_opaque();
  float2* ts = (float2*)(p.ws + O_RSWA); float2* tm = (float2*)(p.ws + O_RMLA);
  for (int i = 0; i < 32; ++i) {
    const float inv = exp2f(-(float)i * (13.287712379549449f / 32.f));
    const float ang = (float)pos * inv;
    const double rev = (double)ang * 0.15915494309189535; const float fr = (float)(rev - floor(rev));
    ts[pos * 32 + i] = make_float2(__builtin_amdgcn_cosf(fr), __builtin_amdgcn_sinf(fr));
  }
  for (int i = 0; i < 16; ++i) {
    const float inv = exp2f(-(float)i * (13.287712379549449f / 16.f));
    const float ang = (float)pos * inv;
    const double rev = (double)ang * 0.15915494309189535; const float fr = (float)(rev - floor(rev));
    tm[pos * 16 + i] = make_float2(__builtin_amdgcn_cosf(fr), __builtin_amdgcn_sinf(fr));
  }
}

DI void normmod_item(const float* __restrict__ xl, const float* __restrict__ xc, const float* __restrict__ w, const float* __restrict__ modl,
                     int shift_off, int scale_off, bf16_t* __restrict__ H, int it) {
  const int lane = tid_opaque() & 63, wid = tid_opaque() >> 6;
#pragma unroll 1
  for (int rr = 0; rr < 4; ++rr) {
    const long g = (long)it * 16 + wid * 4 + rr;
    const float* src = (g < NLAT) ? xl + g * DM : xc + (g - NLAT) * DM;
    const int v = (g < NLAT) ? (int)(g >> 14) : 2;
    float4 xv[4]; float ss = 0;
#pragma unroll
    for (int i = 0; i < 4; ++i) { xv[i] = *(const float4*)(src + i * 256 + lane * 4); ss += xv[i].x * xv[i].x + xv[i].y * xv[i].y + xv[i].z * xv[i].z + xv[i].w * xv[i].w; }
    ss = wave_sum(ss);
    const float rinv = rsqrtf(ss * (1.f / DM) + EPS);
    const float* sh = modl + v * 6144 + shift_off; const float* sc = modl + v * 6144 + scale_off;
#pragma unroll
    for (int i = 0; i < 4; ++i) {
      const int e = i * 256 + lane * 4;
      const float4 wv = *(const float4*)(w + e), s4 = *(const float4*)(sc + e), h4 = *(const float4*)(sh + e);
      const float y0 = xv[i].x * rinv * wv.x * (1.f + s4.x) + h4.x, y1 = xv[i].y * rinv * wv.y * (1.f + s4.y) + h4.y;
      const float y2 = xv[i].z * rinv * wv.z * (1.f + s4.z) + h4.z, y3 = xv[i].w * rinv * wv.w * (1.f + s4.w) + h4.w;
      u32x2 o = {cvtpk(y0, y1), cvtpk(y2, y3)};
      *(u32x2*)(H + g * DM + e) = o;
    }
  }
}
DI void finalnorm_item(float* __restrict__ x, const float* __restrict__ w, int it) {
  const int lane = tid_opaque() & 63, wid = tid_opaque() >> 6;
#pragma unroll 1
  for (int rr = 0; rr < 4; ++rr) {
    const long g = (long)it * 16 + wid * 4 + rr;
    float* src = x + g * DM;
    float4 xv[4]; float ss = 0;
#pragma unroll
    for (int i = 0; i < 4; ++i) { xv[i] = *(const float4*)(src + i * 256 + lane * 4); ss += xv[i].x * xv[i].x + xv[i].y * xv[i].y + xv[i].z * xv[i].z + xv[i].w * xv[i].w; }
    ss = wave_sum(ss);
    const float rinv = rsqrtf(ss * (1.f / DM) + EPS);
#pragma unroll
    for (int i = 0; i < 4; ++i) {
      const int e = i * 256 + lane * 4;
      const float4 wv = *(const float4*)(w + e);
      float4 o; o.x = xv[i].x * rinv * wv.x; o.y = xv[i].y * rinv * wv.y; o.z = xv[i].z * rinv * wv.z; o.w = xv[i].w * rinv * wv.w;
      *(float4*)(src + e) = o;
    }
  }
}

template <int NT, bool ROWSS, bool ZERO = true>
DI void gemm_core(const bf16_t* __restrict__ A, long lda, const bf16_t* __restrict__ Bt, long ldb, int K, f32x4 (&acc)[4][NT], char* lds) {
  constexpr int BROWS = NT * 32, STAGE = 16384 + BROWS * 128;
  const int tid = tid_opaque(), lane = tid & 63, wid = tid >> 6, fr = lane & 15, fq = lane >> 4, wr = wid >> 1, wc = wid & 1;
  const int lrow = tid >> 3, lch = tid & 7;
  const bf16_t* ap = A + (long)lrow * lda + lch * 8;
  const bf16_t* bp = Bt + (long)lrow * ldb + lch * 8;
  const int woff = lrow * 128 + ((lch ^ ((lrow >> 1) & 7)) << 4);
  bf16x8 ra[4], rb[NT];
  float ss[4] = {0.f, 0.f, 0.f, 0.f};
  if (ZERO) {
#pragma unroll
    for (int m = 0; m < 4; ++m)
#pragma unroll
      for (int n = 0; n < NT; ++n) acc[m][n] = f32x4{0.f, 0.f, 0.f, 0.f};
  }
  __syncthreads();
#pragma unroll
  for (int i = 0; i < 4; ++i) ra[i] = *(const bf16x8*)(ap + (long)i * 32 * lda);
#pragma unroll
  for (int i = 0; i < NT; ++i) rb[i] = *(const bf16x8*)(bp + (long)i * 32 * ldb);
#pragma unroll
  for (int i = 0; i < 4; ++i) *(bf16x8*)(lds + woff + i * 4096) = ra[i];
#pragma unroll
  for (int i = 0; i < NT; ++i) *(bf16x8*)(lds + 16384 + woff + i * 4096) = rb[i];
  if (ROWSS) {
#pragma unroll
    for (int i = 0; i < 4; ++i)
#pragma unroll
      for (int j = 0; j < 8; ++j) { const float f = bf2f((bf16_t)ra[i][j]); ss[i] += f * f; }
  }
  __syncthreads();
  const int nk = K / 64;
  const int sw = fr >> 1;
#pragma unroll 1
  for (int kt = 0; kt < nk; ++kt) {
    const char* sA = lds + (kt & 1) * STAGE; const char* sB = sA + 16384;
    const bool more = (kt + 1 < nk);
    if (more) {
      const int k0 = (kt + 1) * 64;
#pragma unroll
      for (int i = 0; i < 4; ++i) ra[i] = *(const bf16x8*)(ap + (long)i * 32 * lda + k0);
#pragma unroll
      for (int i = 0; i < NT; ++i) rb[i] = *(const bf16x8*)(bp + (long)i * 32 * ldb + k0);
    }
#pragma unroll
    for (int kk = 0; kk < 2; ++kk) {
      bf16x8 af[4], bfr[NT];
      const int ch = ((kk * 4 + fq) ^ sw) << 4;
#pragma unroll
      for (int m = 0; m < 4; ++m) af[m] = *(const bf16x8*)(sA + (wr * 64 + m * 16 + fr) * 128 + ch);
#pragma unroll
      for (int n = 0; n < NT; ++n) bfr[n] = *(const bf16x8*)(sB + (wc * NT * 16 + n * 16 + fr) * 128 + ch);
#pragma unroll
      for (int m = 0; m < 4; ++m)
#pragma unroll
        for (int n = 0; n < NT; ++n) acc[m][n] = MFMA16(af[m], bfr[n], acc[m][n]);
    }
    if (more) {
      char* d = lds + ((kt + 1) & 1) * STAGE;
#pragma unroll
      for (int i = 0; i < 4; ++i) *(bf16x8*)(d + woff + i * 4096) = ra[i];
#pragma unroll
      for (int i = 0; i < NT; ++i) *(bf16x8*)(d + 16384 + woff + i * 4096) = rb[i];
      if (ROWSS) {
#pragma unroll
        for (int i = 0; i < 4; ++i)
#pragma unroll
          for (int j = 0; j < 8; ++j) { const float f = bf2f((bf16_t)ra[i][j]); ss[i] += f * f; }
      }
    }
    __syncthreads();
  }
  if (ROWSS) {
    float* rss = (float*)lds;
#pragma unroll
    for (int i = 0; i < 4; ++i) {
      float v = ss[i]; v += __shfl_xor(v, 1); v += __shfl_xor(v, 2); v += __shfl_xor(v, 4);
      if (lch == 0) rss[lrow + 32 * i] = v;
    }
    __syncthreads();
  }
}

#define ROT(X1, X2, CS) do { const float2 cs_ = (CS); const float a_ = (X1) * cs_.x - (X2) * cs_.y, b_ = (X2) * cs_.x + (X1) * cs_.y; (X1) = a_; (X2) = b_; } while (0)

DI void inproj_item(const Params& p, int l, int b, int rt, int ct, char* lds) {
  const bf16_t* W = (const bf16_t*)(p.ws + O_W) + (long)l * W_LAYER + W_IN;
  const bf16_t* H = (const bf16_t*)(p.ws + O_H);
  const int lr0 = rt * 128;
  f32x4 acc[4][4];
  gemm_core<4, false>(H + grow_of(b, lr0) * DM, DM, W + (long)ct * 128 * 1024, 1024, 1024, acc, lds);
  const int lane = tid_opaque() & 63, wid = tid_opaque() >> 6, fr = lane & 15, fq = lane >> 4, wr = wid >> 1, wc = wid & 1;
  const int c0 = ct * 128 + wc * 64;
  const int rbase = lr0 + wr * 64 + fq * 4;
  const bool latent = lr0 < SEQ;
  bf16_t* dst; int ld, cc;
  int ropek = 0;
  bool ropecol = false;
  if (c0 < 2048) { dst = (bf16_t*)(p.ws + O_R1); ld = 2048; cc = c0; }
  else if (c0 < 3072) { dst = (bf16_t*)(p.ws + O_PR); ld = 1024; cc = c0 - 2048; }
  else if (c0 < 4608) { dst = (bf16_t*)(p.ws + O_R2); ld = 1536; cc = c0 - 3072; if (cc < 1280 && latent) { ropek = 1; ropecol = (cc >> 6) & 1; } }
  else if (c0 < 5312) { dst = (bf16_t*)(p.ws + O_PM); ld = 704; cc = c0 - 4608; if (cc == 640 && latent) ropek = 2; }
  else { dst = (bf16_t*)(p.ws + O_PZ); ld = 32; cc = 0; }
  if (ropek == 1) {
    const float2* tab = (const float2*)(p.ws + O_RSWA);
#pragma unroll
    for (int m = 0; m < 4; ++m)
#pragma unroll
      for (int j = 0; j < 4; ++j) {
        const int t = rbase + m * 16 + j; const int pos = ropecol ? (t & 63) : (t >> 6);
#pragma unroll
        for (int n = 0; n < 2; ++n) ROT(acc[m][n][j], acc[m][n + 2][j], tab[pos * 32 + n * 16 + fr]);
      }
  } else if (ropek == 2) {
    const float2* tab = (const float2*)(p.ws + O_RMLA);
#pragma unroll
    for (int m = 0; m < 4; ++m)
#pragma unroll
      for (int j = 0; j < 4; ++j) {
        const int t = rbase + m * 16 + j;
        ROT(acc[m][0][j], acc[m][1][j], tab[(t >> 6) * 16 + fr]);
        ROT(acc[m][2][j], acc[m][3][j], tab[(t & 63) * 16 + fr]);
      }
  }
  const bool isz = (c0 >= 5312);
#pragma unroll
  for (int m = 0; m < 4; ++m)
#pragma unroll
    for (int n = 0; n < 4; ++n) {
      if (isz && n >= 2) continue;
#pragma unroll
      for (int j = 0; j < 4; ++j) dst[(long)(rbase + m * 16 + j) * ld + cc + n * 16 + fr] = f2bf(acc[m][n][j]);
    }
}

DI void mlaq_item(const Params& p, int l, int rt, int ct, char* lds) {
  const bf16_t* W = (const bf16_t*)(p.ws + O_W) + (long)l * W_LAYER + W_UQ;
  const bf16_t* PM = (const bf16_t*)(p.ws + O_PM);
  bf16_t* Qm = (bf16_t*)(p.ws + O_R1);
  const int lr0 = rt * 128;
  f32x4 acc[4][4];
  gemm_core<4, true>(PM + (long)lr0 * 704, 704, W + (long)ct * 128 * 384, 384, 384, acc, lds);
  const float* rss = (const float*)lds;
  const int lane = tid_opaque() & 63, wid = tid_opaque() >> 6, fr = lane & 15, fq = lane >> 4, wr = wid >> 1, wc = wid & 1;
  const int c0 = ct * 128 + wc * 64;
  const int rl = wr * 64 + fq * 4;
  const bool isrope = ((c0 >> 6) % 3) == 2 && lr0 < SEQ;
  const float2* tab = (const float2*)(p.ws + O_RMLA);
#pragma unroll
  for (int m = 0; m < 4; ++m)
#pragma unroll
    for (int j = 0; j < 4; ++j) {
      const int rloc = rl + m * 16 + j; const int t = lr0 + rloc;
      const float rinv = rsqrtf(rss[rloc] * (1.f / 384.f) + EPS);
      float v0 = acc[m][0][j] * rinv, v1 = acc[m][1][j] * rinv, v2 = acc[m][2][j] * rinv, v3 = acc[m][3][j] * rinv;
      if (isrope) { ROT(v0, v1, tab[(t >> 6) * 16 + fr]); ROT(v2, v3, tab[(t & 63) * 16 + fr]); }
      bf16_t* d = Qm + (long)t * 1536 + c0 + fr;
      d[0] = f2bf(v0); d[16] = f2bf(v1); d[32] = f2bf(v2); d[48] = f2bf(v3);
    }
}
DI void mlakv_item(const Params& p, int l, int rt, int ct, char* lds) {
  const bf16_t* W = (const bf16_t*)(p.ws + O_W) + (long)l * W_LAYER + W_UKV;
  const bf16_t* PM = (const bf16_t*)(p.ws + O_PM);
  bf16_t* Km = (bf16_t*)(p.ws + O_KM); bf16_t* Vm = (bf16_t*)(p.ws + O_VM);
  const int lr0 = rt * 128;
  f32x4 acc[4][4];
  gemm_core<4, true>(PM + (long)lr0 * 704 + 384, 704, W + (long)ct * 128 * 256, 256, 256, acc, lds);
  const float* rss = (const float*)lds;
  const int lane = tid_opaque() & 63, wid = tid_opaque() >> 6, fr = lane & 15, fq = lane >> 4, wr = wid >> 1, wc = wid & 1;
  const int c0 = ct * 128 + wc * 64;
  const int head = c0 >> 8, within = c0 & 255;
  const int rl = wr * 64 + fq * 4;
  bf16_t* dst; int ld;
  if (within < 128) { dst = Km + head * 192 + within; ld = 1536; } else { dst = Vm + head * 128 + (within - 128); ld = 1024; }
#pragma unroll
  for (int m = 0; m < 4; ++m)
#pragma unroll
    for (int j = 0; j < 4; ++j) {
      const int rloc = rl + m * 16 + j; const int t = lr0 + rloc;
      const float rinv = rsqrtf(rss[rloc] * (1.f / 256.f) + EPS);
      bf16_t* d = dst + (long)t * ld + fr;
#pragma unroll
      for (int n = 0; n < 4; ++n) d[n * 16] = f2bf(acc[m][n][j] * rinv);
    }
}
DI void krdup_item(const Params& p, int it) {
  const bf16_t* PM = (const bf16_t*)(p.ws + O_PM); bf16_t* Km = (bf16_t*)(p.ws + O_KM);
  const int tid = tid_opaque(); const int r = it * 16 + (tid >> 4); const int q = tid & 15;
  const int h = q >> 1, half = q & 1;
  const u32x4* s = (const u32x4*)(PM + (long)r * 704 + 640 + half * 32);
  u32x4* d = (u32x4*)(Km + (long)r * 1536 + h * 192 + 128 + half * 32);
#pragma unroll
  for (int i = 0; i < 4; ++i) d[i] = s[i];
}

DI void merge_item(const Params& p, int l, int b, int rt, int ct, char* lds) {
  const bf16_t* W = (const bf16_t*)(p.ws + O_W) + (long)l * W_LAYER;
  const bf16_t* H = (const bf16_t*)(p.ws + O_H);
  const int lr0 = rt * 128;
  const bf16_t* Hrow = H + grow_of(b, lr0) * DM;
  f32x4 tot[4][4], acc[4][4];
  unsigned gp[4][4][2];
#pragma unroll
  for (int m = 0; m < 4; ++m)
#pragma unroll
    for (int n = 0; n < 4; ++n) tot[m][n] = f32x4{0, 0, 0, 0};
#pragma unroll 1
  for (int i = 0; i < 3; ++i) {
    const bf16_t* O = (const bf16_t*)(p.ws + (i == 0 ? O_PR : (i == 1 ? O_OSW : O_R2)));
    gemm_core<4, false>(Hrow, DM, W + W_G + ((long)i * 1024 + ct * 128) * 1024, 1024, 1024, acc, lds);
#pragma unroll
    for (int m = 0; m < 4; ++m)
#pragma unroll
      for (int n = 0; n < 4; ++n) {
        float g0 = fmaxf(sigmoidf_(acc[m][n][0]), 1e-20f), g1 = fmaxf(sigmoidf_(acc[m][n][1]), 1e-20f);
        float g2 = fmaxf(sigmoidf_(acc[m][n][2]), 1e-20f), g3 = fmaxf(sigmoidf_(acc[m][n][3]), 1e-20f);
        gp[m][n][0] = cvtpk(g0, g1); gp[m][n][1] = cvtpk(g2, g3);
        tot[m][n][0] = tot[m][n][0] / bflo(gp[m][n][0]); tot[m][n][1] = tot[m][n][1] / bfhi(gp[m][n][0]);
        tot[m][n][2] = tot[m][n][2] / bflo(gp[m][n][1]); tot[m][n][3] = tot[m][n][3] / bfhi(gp[m][n][1]);
      }
    gemm_core<4, false, false>(O + (long)lr0 * 1024, 1024, W + W_B + ((long)i * 1024 + ct * 128) * 1024, 1024, 1024, tot, lds);
#pragma unroll
    for (int m = 0; m < 4; ++m)
#pragma unroll
      for (int n = 0; n < 4; ++n) {
        tot[m][n][0] *= bflo(gp[m][n][0]); tot[m][n][1] *= bfhi(gp[m][n][0]);
        tot[m][n][2] *= bflo(gp[m][n][1]); tot[m][n][3] *= bfhi(gp[m][n][1]);
      }
  }
  const int lane = tid_opaque() & 63, wid = tid_opaque() >> 6, fr = lane & 15, fq = lane >> 4, wr = wid >> 1, wc = wid & 1;
  bf16_t* Mg = (bf16_t*)(p.ws + O_R1);
#pragma unroll
  for (int m = 0; m < 4; ++m)
#pragma unroll
    for (int n = 0; n < 4; ++n)
#pragma unroll
      for (int j = 0; j < 4; ++j)
        Mg[(long)(lr0 + wr * 64 + m * 16 + fq * 4 + j) * 1024 + ct * 128 + wc * 64 + n * 16 + fr] = f2bf(tot[m][n][j]);
}

DI void resid_item(const bf16_t* A, long lda, const bf16_t* Bt, int K, const float* gate, const float* xsrc, float* xdst, int ct, char* lds) {
  f32x4 acc[4][4];
  gemm_core<4, false>(A, lda, Bt + (long)ct * 128 * K, K, K, acc, lds);
  const int lane = tid_opaque() & 63, wid = tid_opaque() >> 6, fr = lane & 15, fq = lane >> 4, wr = wid >> 1, wc = wid & 1;
#pragma unroll
  for (int n = 0; n < 4; ++n) {
    const int col = ct * 128 + wc * 64 + n * 16 + fr;
    const float gt = gate[col];
#pragma unroll
    for (int m = 0; m < 4; ++m)
#pragma unroll
      for (int j = 0; j < 4; ++j) {
        const long o = (long)(wr * 64 + m * 16 + fq * 4 + j) * DM + col;
        xdst[o] = xsrc[o] + gt * acc[m][n][j];
      }
  }
}
DI void mlp1_item(const Params& p, int l, int rt, int ct, char* lds) {
  const bf16_t* W = (const bf16_t*)(p.ws + O_W) + (long)l * W_LAYER + W_1;
  const bf16_t* H = (const bf16_t*)(p.ws + O_H);
  bf16_t* U = (bf16_t*)(p.ws + O_U);
  f32x4 acc[4][4];
  gemm_core<4, false>(H + (long)rt * 128 * DM, DM, W + (long)ct * 128 * 1024, 1024, 1024, acc, lds);
  const int lane = tid_opaque() & 63, wid = tid_opaque() >> 6, fr = lane & 15, fq = lane >> 4, wr = wid >> 1, wc = wid & 1;
#pragma unroll
  for (int m = 0; m < 4; ++m)
#pragma unroll
    for (int n = 0; n < 4; ++n)
#pragma unroll
      for (int j = 0; j < 4; ++j) {
        const float v = fmaxf(acc[m][n][j], 0.f);
        U[(long)(rt * 128 + wr * 64 + m * 16 + fq * 4 + j) * 4096 + ct * 128 + wc * 64 + n * 16 + fr] = f2bf(v * v);
      }
}

template <int DIR>
DI void glaprep_body(const Params& p, int l, int c, int h, char* lds) {
  const int tid = tid_opaque(), d = tid & 127, hf = tid >> 7;
  float* zs = (float*)lds;
  float* hs = zs + 1024;
  const bf16_t* PZ = (const bf16_t*)(p.ws + O_PZ);
  const bf16_t* PG = (const bf16_t*)(p.ws + O_R1);
  const int lr0 = c * 64;
  __syncthreads();
#pragma unroll
  for (int i = 0; i < 4; ++i) { const int e = tid + 256 * i; zs[e] = bf2f(PZ[(long)(lr0 + (e >> 4)) * 32 + DIR * 16 + (e & 15)]); }
  float aw[16];
  const float* awp = p.gla_a_w + ((long)(l * 2 + DIR) * 16) * 512 + h * 128 + d;
#pragma unroll
  for (int r = 0; r < 16; ++r) aw[r] = awp[r * 512];
  const float ab = p.gla_a_b[(l * 2 + DIR) * 512 + h * 128 + d];
  __syncthreads();
  float la[32]; float sum = 0.f;
#pragma unroll
  for (int ii = 0; ii < 32; ++ii) {
    const float* z = zs + (hf * 32 + ii) * 16;
    float x = ab;
#pragma unroll
    for (int r = 0; r < 16; ++r) x += z[r] * aw[r];
    const float ls = fminf(x, 0.f) - __logf(1.f + __expf(-fabsf(x)));
    la[ii] = ls * (1.f / 16.f); sum += la[ii];
  }
  hs[hf * 128 + d] = sum;
  __syncthreads();
  const float other = hs[(1 - hf) * 128 + d];
  const float total = sum + other;
  bf16_t* QD = (bf16_t*)(p.ws + (DIR ? O_VM : O_KM));
  bf16_t* KI = QD + (long)TB * 512;
  float run = (DIR == 0) ? (hf == 1 ? other : 0.f) : (hf == 0 ? other : 0.f);
#pragma unroll
  for (int s = 0; s < 32; ++s) {
    const int ii = (DIR == 0) ? s : 31 - s;
    run += la[ii];
    const long row = lr0 + hf * 32 + ii;
    const float q = bf2f(PG[row * 2048 + h * 128 + d]);
    const float k = bf2f(PG[row * 2048 + 512 + h * 128 + d]);
    const float e = __expf(run);
    QD[row * 512 + h * 128 + d] = f2bf(q * e);
    KI[row * 512 + h * 128 + d] = f2bf(k * __expf(-run));
  }
  if (hf == 0) ((float*)(p.ws + O_GT))[((long)DIR * 260 + c) * 512 + h * 128 + d] = __expf(total);
}

DI int swz256(int row, int cb) { return row * 256 + (cb ^ ((row & 7) << 4)); }
DI int v_st(int k, int c) { const int kk = (k & ~0xC) | ((k & 4) << 1) | ((k & 8) >> 1); return ((kk >> 3) * 4 + (c >> 5)) * 512 + ((kk & 7) * 32 + (c & 31)) * 2; }
DI int v_st32(int k, int c) { const int kk = (k & ~0xC) | ((k & 4) << 1) | ((k & 8) >> 1); return (kk >> 3) * 512 + ((kk & 7) * 32 + c) * 2; }
DI int v_rd_base(int lane) { return ((lane & 3) << 3) | (((lane >> 2) & 3) << 6) | (((lane >> 4) & 1) << 5) | (((lane >> 5) & 1) << 8); }
constexpr int v_rd_off(int d0, int ks, int half) { return d0 * 512 + ks * 4096 + half * 2048; }
typedef __attribute__((address_space(3))) s16x4* lds_v4p;
template <int OFF> DI s16x4 tr_read(int vb) { return __builtin_amdgcn_ds_read_tr16_b64_v4i16((lds_v4p)(unsigned)(vb + OFF)); }
#define PKF(L, H) (bf16x8){L[0], L[1], L[2], L[3], H[0], H[1], H[2], H[3]}
#define PK4(P, BASE, OUT) do { unsigned a0_ = cvtpk(P[BASE + 0], P[BASE + 1]), a1_ = cvtpk(P[BASE + 2], P[BASE + 3]);   \
    unsigned b0_ = cvtpk(P[BASE + 4], P[BASE + 5]), b1_ = cvtpk(P[BASE + 6], P[BASE + 7]);                              \
    auto r0_ = __builtin_amdgcn_permlane32_swap(a0_, b0_, false, false); auto r1_ = __builtin_amdgcn_permlane32_swap(a1_, b1_, false, false); \
    u32x4 w_ = {r0_[0], r1_[0], r0_[1], r1_[1]}; OUT = *reinterpret_cast<bf16x8*>(&w_); } while (0)

DI int gla_gs(int g) { return g <= 4 ? 33 * g : 132 + 32 * (g - 4); }
template <int DIR, int MODE>
DI void gla_body(const Params& p, int h, int sl, int grp, char* lds) {
  const int tid = tid_opaque(), lane = tid & 63, wid = tid >> 6, r32 = lane & 31, hi = lane >> 5;
  char* sQD = lds; char* sKI = lds + 16384; char* sKIv = lds + 32768; char* sV = lds + 49152; char* sST = lds + 53248;
  float* sG = (float*)(lds + 61952);
  const bf16_t* QD = (const bf16_t*)(p.ws + (DIR ? O_VM : O_KM)) + h * 128;
  const bf16_t* KI = QD + (long)TB * 512;
  const bf16_t* PV = (const bf16_t*)(p.ws + O_R1) + 1024 + h * 256 + sl * 32;
  const float* GT = (const float*)(p.ws + O_GT) + (long)DIR * 260 * 512 + h * 128;
  bf16_t* Oo = (bf16_t*)(p.ws + (DIR ? O_OB : O_OF)) + (long)(h * 8 + sl) * TB * 32;
  const int it0 = ((h * 2 + DIR) * 8 + sl) * 8;
  float* SE = (float*)(p.ws + O_SE); float* GTOT = (float*)(p.ws + O_GTOT);
  const int s_begin = gla_gs(grp), s_end = gla_gs(grp + 1);
  f32x16 S, gacc;
#pragma unroll
  for (int r = 0; r < 16; ++r) { S[r] = 0.f; gacc[r] = 1.f; }
  if (MODE == 1) {
    if (grp == 0) return;
    for (int g = 0; g < grp; ++g) {
      const float* se = SE + (long)(it0 + g) * 4096; const float* gt = GTOT + (long)(it0 + g) * 128;
#pragma unroll
      for (int r = 0; r < 16; ++r) { const int d = wid * 32 + crow(r, hi); S[r] = gt[d] * S[r] + se[d * 32 + r32]; }
    }
  }
  bf16x8 rq[4], rk[4], rv; float rg = 0.f;
  const int srow = tid >> 4, sdc = tid & 15;
  const int vrow = tid >> 2, vpc = tid & 3;
  const int kvb = (int)(uintptr_t)sKIv + v_rd_base(lane) + wid * 512;
  const int vvb = (int)(uintptr_t)sV + v_rd_base(lane);
#define GLA_LOAD(cc) do { const long r0 = (long)(cc) * 64;                                                           \
    _Pragma("unroll") for (int i = 0; i < 4; ++i) { rq[i] = *(const bf16x8*)(QD + (r0 + srow + 16 * i) * 512 + sdc * 8);  \
      if (MODE == 0) rk[i] = *(const bf16x8*)(KI + (r0 + srow + 16 * i) * 512 + sdc * 8); }                          \
    if (MODE == 0) rv = *(const bf16x8*)(PV + (r0 + vrow) * 2048 + vpc * 8);                                         \
    if (tid < 128) rg = GT[(long)(cc) * 512 + tid]; } while (0)
  auto chunk_of = [&](int s) { return (DIR == 0) ? (s < 4 ? 256 + s : s - 4) : 259 - s; };
  __syncthreads();
  GLA_LOAD(chunk_of(s_begin));
#pragma unroll 1
  for (int s = s_begin; s < s_end; ++s) {
    const int c = chunk_of(s);
    __syncthreads();
#pragma unroll
    for (int i = 0; i < 4; ++i) {
      const int row = srow + 16 * i;
      *(bf16x8*)(sQD + swz256(row, sdc * 16)) = rq[i];
      if (MODE == 0) {
        *(bf16x8*)(sKI + swz256(row, sdc * 16)) = rk[i];
        *(bf16x8*)(sKIv + v_st(row, sdc * 8)) = rk[i];
      }
    }
    if (MODE == 0) *(bf16x8*)(sV + v_st32(vrow, vpc * 8)) = rv;
    if (tid < 128) sG[tid] = rg;
#pragma unroll
    for (int g = 0; g < 4; ++g) {
      u32x2 w = {cvtpk(S[4 * g], S[4 * g + 1]), cvtpk(S[4 * g + 2], S[4 * g + 3])};
      *(u32x2*)(sST + r32 * 272 + (wid * 32 + 8 * g + 4 * hi) * 2) = w;
    }
    __syncthreads();
    if (s + 1 < s_end) GLA_LOAD(chunk_of(s + 1));
    if (MODE == 0) {
      const s16x4 vl0 = tr_read<0>(vvb), vh0 = tr_read<512>(vvb), vl1 = tr_read<1024>(vvb), vh1 = tr_read<1536>(vvb);
      const s16x4 vl2 = tr_read<2048>(vvb), vh2 = tr_read<2560>(vvb), vl3 = tr_read<3072>(vvb), vh3 = tr_read<3584>(vvb);
      const bf16x8 vf0 = PKF(vl0, vh0), vf1 = PKF(vl1, vh1), vf2 = PKF(vl2, vh2), vf3 = PKF(vl3, vh3);
      if (wid < 2) {
        const int ib = wid;
        f32x16 X0, X1, o;
#pragma unroll
        for (int r = 0; r < 16; ++r) { X0[r] = 0.f; X1[r] = 0.f; o[r] = 0.f; }
#pragma unroll
        for (int ks = 0; ks < 8; ++ks) {
          const int cb = (ks * 16 + hi * 8) * 2;
          const bf16x8 qf = *(const bf16x8*)(sQD + swz256(ib * 32 + r32, cb));
          const bf16x8 k0 = *(const bf16x8*)(sKI + swz256(r32, cb));
          const bf16x8 k1 = *(const bf16x8*)(sKI + swz256(32 + r32, cb));
          X0 = MFMA32(k0, qf, X0); X1 = MFMA32(k1, qf, X1);
          const bf16x8 sf = *(const bf16x8*)(sST + r32 * 272 + cb);
          o = MFMA32(qf, sf, o);
        }
        const int iq = ib * 32 + r32;
#pragma unroll
        for (int r = 0; r < 16; ++r) {
          const int j0 = crow(r, hi), j1 = 32 + j0;
          const bool v0 = (DIR == 0) ? (j0 <= iq) : (j0 >= iq);
          const bool v1 = (DIR == 0) ? (j1 <= iq) : (j1 >= iq);
          X0[r] = v0 ? X0[r] : 0.f; X1[r] = v1 ? X1[r] : 0.f;
        }
        bf16x8 pa0, pa1, pa2, pa3;
        PK4(X0, 0, pa0); PK4(X0, 8, pa1); PK4(X1, 0, pa2); PK4(X1, 8, pa3);
        o = MFMA32(pa0, vf0, o); o = MFMA32(pa1, vf1, o); o = MFMA32(pa2, vf2, o); o = MFMA32(pa3, vf3, o);
        bf16_t* od = Oo + ((long)c * 64 + ib * 32) * 32 + r32;
#pragma unroll
        for (int r = 0; r < 16; ++r) od[crow(r, hi) * 32] = f2bf(o[r]);
      }
      {
        const s16x4 al0 = tr_read<v_rd_off(0, 0, 0)>(kvb), ah0 = tr_read<v_rd_off(0, 0, 1)>(kvb), al1 = tr_read<v_rd_off(0, 1, 0)>(kvb), ah1 = tr_read<v_rd_off(0, 1, 1)>(kvb);
        const s16x4 al2 = tr_read<v_rd_off(0, 2, 0)>(kvb), ah2 = tr_read<v_rd_off(0, 2, 1)>(kvb), al3 = tr_read<v_rd_off(0, 3, 0)>(kvb), ah3 = tr_read<v_rd_off(0, 3, 1)>(kvb);
        S = MFMA32(PKF(al0, ah0), vf0, S); S = MFMA32(PKF(al1, ah1), vf1, S);
        S = MFMA32(PKF(al2, ah2), vf2, S); S = MFMA32(PKF(al3, ah3), vf3, S);
      }
    } else {
      if (wid < 2) {
        const int ib = wid;
        f32x16 o;
#pragma unroll
        for (int r = 0; r < 16; ++r) o[r] = 0.f;
#pragma unroll
        for (int ks = 0; ks < 8; ++ks) {
          const int cb = (ks * 16 + hi * 8) * 2;
          const bf16x8 qf = *(const bf16x8*)(sQD + swz256(ib * 32 + r32, cb));
          const bf16x8 sf = *(const bf16x8*)(sST + r32 * 272 + cb);
          o = MFMA32(qf, sf, o);
        }
        bf16_t* od = Oo + ((long)c * 64 + ib * 32) * 32 + r32;
#pragma unroll
        for (int r = 0; r < 16; ++r) { bf16_t* q_ = od + crow(r, hi) * 32; *q_ = f2bf(bf2f(*q_) + o[r]); }
      }
    }
#pragma unroll
    for (int r = 0; r < 16; ++r) { const float g = sG[wid * 32 + crow(r, hi)]; S[r] *= g; gacc[r] *= g; }
  }
#undef GLA_LOAD
  if (MODE == 0) {
    float* se = SE + (long)(it0 + grp) * 4096; float* gt = GTOT + (long)(it0 + grp) * 128;
#pragma unroll
    for (int r = 0; r < 16; ++r) { const int d = wid * 32 + crow(r, hi); se[d * 32 + r32] = S[r]; if (r32 == 0) gt[d] = gacc[r]; }
  }
  __syncthreads();
}

DI void glapost_item(const Params& p, int l, int it) {
  const int lane = tid_opaque() & 63, wid = tid_opaque() >> 6;
  const bf16_t* OF = (const bf16_t*)(p.ws + O_OF); const bf16_t* OB = (const bf16_t*)(p.ws + O_OB); bf16_t* PR = (bf16_t*)(p.ws + O_PR);
  const float4 wv = *(const float4*)(p.gla_norm_w + l * 256 + lane * 4);
#pragma unroll 1
  for (int rr = 0; rr < 4; ++rr) {
    const long row = (long)it * 16 + wid * 4 + rr;
#pragma unroll
    for (int h = 0; h < 4; ++h) {
      const long o = row * 1024 + h * 256 + lane * 4;
      const long os = ((long)(h * 8 + (lane >> 3)) * TB + row) * 32 + (lane & 7) * 4;
      const u32x2 a = *(const u32x2*)(OF + os), b = *(const u32x2*)(OB + os), g = *(const u32x2*)(PR + o);
      const float x0 = bflo(a[0]) + bflo(b[0]), x1 = bfhi(a[0]) + bfhi(b[0]), x2 = bflo(a[1]) + bflo(b[1]), x3 = bfhi(a[1]) + bfhi(b[1]);
      const float ss = wave_sum(x0 * x0 + x1 * x1 + x2 * x2 + x3 * x3);
      const float rinv = rsqrtf(ss * (1.f / 256.f) + EPS);
      const float g0 = bflo(g[0]), g1 = bfhi(g[0]), g2 = bflo(g[1]), g3 = bfhi(g[1]);
      const float y0 = x0 * rinv * wv.x * g0 * sigmoidf_(g0), y1 = x1 * rinv * wv.y * g1 * sigmoidf_(g1);
      const float y2 = x2 * rinv * wv.z * g2 * sigmoidf_(g2), y3 = x3 * rinv * wv.w * g3 * sigmoidf_(g3);
      u32x2 w = {cvtpk(y0, y1), cvtpk(y2, y3)};
      *(u32x2*)(PR + o) = w;
    }
  }
}

template <int D0> DI void pv_one(f32x16& od, int vb, bf16x8 pa0, bf16x8 pa1, bf16x8 pa2, bf16x8 pa3) {
  const s16x4 l0 = tr_read<v_rd_off(D0, 0, 0)>(vb), h0 = tr_read<v_rd_off(D0, 0, 1)>(vb), l1 = tr_read<v_rd_off(D0, 1, 0)>(vb), h1 = tr_read<v_rd_off(D0, 1, 1)>(vb);
  const s16x4 l2 = tr_read<v_rd_off(D0, 2, 0)>(vb), h2 = tr_read<v_rd_off(D0, 2, 1)>(vb), l3 = tr_read<v_rd_off(D0, 3, 0)>(vb), h3 = tr_read<v_rd_off(D0, 3, 1)>(vb);
#define PK(L, H) (bf16x8){L[0], L[1], L[2], L[3], H[0], H[1], H[2], H[3]}
  od = MFMA32(pa0, PK(l0, h0), od);
  od = MFMA32(pa1, PK(l1, h1), od);
  od = MFMA32(pa2, PK(l2, h2), od);
  od = MFMA32(pa3, PK(l3, h3), od);
#undef PK
}

template <int DQ, bool WINDOW>
DI void attn_item(const bf16_t* __restrict__ Q, int ldq, const bf16_t* __restrict__ Kp, int ldk, const bf16_t* __restrict__ Vp, int ldv,
                  bf16_t* __restrict__ O, int ldo, int q_row0, int a0, int a1, int b0, int b1, float scale, bool has_sink, float sink, char* lds) {
  constexpr int NQ = DQ / 16, CPR = DQ / 8, NCH = 64 * CPR / 256, KROW = DQ * 2;
  constexpr float THR = 8.f;
  const int tid = tid_opaque(), wid = tid >> 6, lane = tid & 63, r32 = lane & 31, hi = lane >> 5;
  char* V_lds = lds; char* K_lds = lds + 16384;
  float* wsf = (float*)(lds + 16384 + 64 * KROW) + wid * 64; float* li_l = wsf; float* al_l = wsf + 32;
  const float C = scale * LOG2E;
  float m_reg = -1e30f, l_reg = 0.f;
  f32x16 o[4];
#pragma unroll
  for (int d = 0; d < 4; ++d)
#pragma unroll
    for (int r = 0; r < 16; ++r) o[d][r] = 0.f;
  bf16x8 qr[NQ];
  {
    const bf16_t* Qw = Q + (long)(q_row0 + wid * 32 + r32) * ldq + hi * 8;
#pragma unroll
    for (int d0 = 0; d0 < NQ; ++d0) qr[d0] = *(const bf16x8*)(Qw + d0 * 16);
  }
  const int vsr = tid >> 4, vsc = (tid & 15) * 8;
  const int vb0 = (int)(uintptr_t)V_lds + v_rd_base(lane);
  bf16x8 sk[NCH], sv[4];
  const int na = a1 - a0, nt = na + (b1 - b0);
#define ATT_LOAD(t) do { const long kr0 = (long)(t) * 64;                                                                  \
    _Pragma("unroll") for (int i = 0; i < NCH; ++i) { const int e = tid + 256 * i; const int row = e / CPR, ch = e % CPR;   \
      sk[i] = *(const bf16x8*)(Kp + (kr0 + row) * ldk + ch * 8); }                                                         \
    _Pragma("unroll") for (int i = 0; i < 4; ++i) sv[i] = *(const bf16x8*)(Vp + (kr0 + vsr + 16 * i) * ldv + vsc); } while (0)
  ATT_LOAD(na > 0 ? a0 : b0);
  const int qpos = q_row0 + wid * 32 + r32;
#pragma unroll 1
  for (int s = 0; s < nt; ++s) {
    const int t = (s < na) ? a0 + s : b0 + (s - na);
    __syncthreads();
#pragma unroll
    for (int i = 0; i < NCH; ++i) { const int e = tid + 256 * i; const int row = e / CPR, ch = e % CPR;
      *(bf16x8*)(K_lds + row * KROW + ((ch * 16) ^ (((row >> 1) & 7) << 4))) = sk[i]; }
#pragma unroll
    for (int i = 0; i < 4; ++i) *(bf16x8*)(V_lds + v_st(vsr + 16 * i, vsc)) = sv[i];
    __syncthreads();
    if (s + 1 < nt) { const int tn = (s + 1 < na) ? a0 + s + 1 : b0 + (s + 1 - na); ATT_LOAD(tn); }
    f32x16 p0, p1;
#pragma unroll
    for (int r = 0; r < 16; ++r) { p0[r] = 0.f; p1[r] = 0.f; }
#pragma unroll
    for (int d0 = 0; d0 < NQ; ++d0) {
      const int cb = (d0 * 16 + hi * 8) * 2;
      const bf16x8 k0 = *(const bf16x8*)(K_lds + r32 * KROW + (cb ^ (((r32 >> 1) & 7) << 4)));
      const bf16x8 k1 = *(const bf16x8*)(K_lds + (32 + r32) * KROW + (cb ^ (((r32 >> 1) & 7) << 4)));
      p0 = MFMA32(k0, qr[d0], p0);
      p1 = MFMA32(k1, qr[d0], p1);
    }
    if (WINDOW && s >= na) {
      const int kbase = t * 64;
#pragma unroll
      for (int r = 0; r < 16; ++r) {
        const int k0p = kbase + crow(r, hi), k1p = k0p + 32;
        const int d0 = qpos - k0p, d1 = qpos - k1p;
        if (d0 > 128 || d0 < -128) p0[r] = -1e30f;
        if (d1 > 128 || d1 < -128) p1[r] = -1e30f;
      }
    }
    float pmax = p0[0];
#pragma unroll
    for (int r = 1; r < 16; ++r) pmax = fmaxf(pmax, p0[r]);
#pragma unroll
    for (int r = 0; r < 16; ++r) pmax = fmaxf(pmax, p1[r]);
    { auto rr = __builtin_amdgcn_permlane32_swap(__float_as_uint(pmax), __float_as_uint(pmax), false, false);
      pmax = fmaxf(__uint_as_float(rr[0]), __uint_as_float(rr[1])); }
    float mn, alpha;
    if (__all(pmax - m_reg <= THR / scale)) { mn = m_reg; alpha = 1.f; }
    else { mn = fmaxf(m_reg, pmax); alpha = __builtin_amdgcn_exp2f((m_reg - mn) * C); m_reg = mn; }
    const float mnC = -mn * C;
    float ps = 0.f;
#pragma unroll
    for (int r = 0; r < 16; ++r) { p0[r] = __builtin_amdgcn_exp2f(fmaf(p0[r], C, mnC)); ps += p0[r]; }
#pragma unroll
    for (int r = 0; r < 16; ++r) { p1[r] = __builtin_amdgcn_exp2f(fmaf(p1[r], C, mnC)); ps += p1[r]; }
    { auto rr = __builtin_amdgcn_permlane32_swap(__float_as_uint(ps), __float_as_uint(ps), false, false);
      ps = __uint_as_float(rr[0]) + __uint_as_float(rr[1]); }
    l_reg = l_reg * alpha + ps;
    bf16x8 pa0, pa1, pa2, pa3;
    PK4(p0, 0, pa0); PK4(p0, 8, pa1); PK4(p1, 0, pa2); PK4(p1, 8, pa3);
    if (__any(alpha < 1.f)) {
      if (hi == 0) al_l[r32] = alpha;
      asm volatile("s_waitcnt lgkmcnt(0)" ::: "memory");
#pragma unroll
      for (int r = 0; r < 16; ++r) { const float a = al_l[crow(r, hi)];
#pragma unroll
        for (int d = 0; d < 4; ++d) o[d][r] *= a; }
    }
    SBAR();
    pv_one<0>(o[0], vb0, pa0, pa1, pa2, pa3); pv_one<1>(o[1], vb0, pa0, pa1, pa2, pa3);
    pv_one<2>(o[2], vb0, pa0, pa1, pa2, pa3); pv_one<3>(o[3], vb0, pa0, pa1, pa2, pa3);
  }
#undef ATT_LOAD
  if (has_sink) l_reg += __builtin_amdgcn_exp2f(sink * LOG2E - m_reg * C);
  if (hi == 0) li_l[r32] = l_reg;
  asm volatile("s_waitcnt lgkmcnt(0)" ::: "memory");
  bf16_t* Ow = O + (long)(q_row0 + wid * 32) * ldo + r32;
#pragma unroll
  for (int r = 0; r < 16; ++r) {
    const int orow = crow(r, hi);
    const float rl = 1.f / li_l[orow];
#pragma unroll
    for (int d0 = 0; d0 < 4; ++d0) Ow[(long)orow * ldo + d0 * 32] = f2bf(o[d0][r] * rl);
  }
  __syncthreads();
}

constexpr int N_PHASES = 42;

struct Sched { int x, j, nj, nx; };

template <class F>
DI void for_rows(const Sched& sc, int b, bool with_ctx, int C, F f) {
  const int nx = sc.nx;
  const int nlat = (b < 0) ? 256 : 128, nctx = with_ctx ? ((b < 0) ? 4 : 2) : 0;
  const int goff = (b < 0) ? 0 : 128 * b, coff = (b < 0) ? 256 : 256 + 2 * b;
  const int fl = ((sc.x - goff) % nx + nx) % nx;
  const int fc = ((sc.x - coff) % nx + nx) % nx;
  const int nl = (fl < nlat) ? (nlat - fl + nx - 1) / nx : 0;
  const int nc = (fc < nctx) ? (nctx - fc + nx - 1) / nx : 0;
  for (int i = sc.j; i < (nl + nc) * C; i += sc.nj) {
    const int k = i / C, c = i - k * C;
    const int rt = (k < nl) ? fl + k * nx : nlat + fc + (k - nl) * nx;
    f(rt, c);
  }
}

__device__ void run_phase(const Params& p, const Sched& sc, int ph, char* lds) {
  const int bid = blockIdx.x, nblk = gridDim.x;
  float* mod = (float*)(p.ws + O_MOD);
  float* Xc = (float*)(p.ws + O_XC);
  bf16_t* H = (bf16_t*)(p.ws + O_H);
  if (ph == 0) {
    const int n = DEPTH * CONV_PER_LAYER + 192 + 1;
    for (int it = bid; it < n; it += nblk) {
      if (it < 192) adaln_item(p, it, lds);
      else if (it < 192 + DEPTH * CONV_PER_LAYER) conv_item(p, it - 192, lds);
      else rope_item(p);
    }
    return;
  }
  if (ph == N_PHASES - 1) {
    for_rows(sc, -1, false, 8, [&](int rt, int c) { finalnorm_item(p.out, p.final_norm_w, rt * 8 + c); });
    return;
  }
  const int l = (ph - 1) / 20, q = (ph - 1) % 20;
  const bool wctx = (l < DEPTH - 1);
  const float* modl = mod + (long)l * 3 * 6144;
  const bf16_t* W = (const bf16_t*)(p.ws + O_W) + (long)l * W_LAYER;
  if (q == 0) {
    const float* xl = (l == 0) ? p.x : p.out; const float* xc = (l == 0) ? p.ctx : Xc;
    for_rows(sc, -1, true, 8, [&](int rt, int c) { normmod_item(xl, xc, p.norm_mix_w + l * DM, modl, 0, 1024, H, rt * 8 + c); });
    return;
  }
  if (q >= 17) {
    if (q == 17) { for_rows(sc, -1, wctx, 8, [&](int rt, int c) { normmod_item(p.out, Xc, p.norm_mlp_w + l * DM, modl, 3072, 4096, H, rt * 8 + c); }); return; }
    if (q == 18) { for_rows(sc, -1, wctx, 32, [&](int rt, int c) { mlp1_item(p, l, rt, c, lds); }); return; }
    for_rows(sc, -1, wctx, 8, [&](int rt, int ct) {
      const long g0 = (long)rt * 128;
      float* xd = (g0 < NLAT) ? p.out + g0 * DM : Xc + (g0 - NLAT) * DM;
      const int v = (g0 < NLAT) ? (int)(g0 >> 14) : 2;
      resid_item((const bf16_t*)(p.ws + O_U) + g0 * 4096, 4096, W + W_2, 4096, modl + v * 6144 + 5120, xd, xd, ct, lds);
    });
    return;
  }
  const int b = (q - 1) / 8, s8 = (q - 1) % 8;
  if (s8 == 3) {
    for (int it = bid; it < 512; it += nblk) { const int grp = it & 7, sl = (it >> 3) & 7, dir = (it >> 6) & 1, h = it >> 7;
      if (dir) gla_body<1, 1>(p, h, sl, grp, lds); else gla_body<0, 1>(p, h, sl, grp, lds); }
    return;
  }
  const int s = (s8 < 3) ? s8 : s8 - 1;
  if (s == 0) { for_rows(sc, b, true, 42, [&](int rt, int ct) { inproj_item(p, l, b, rt, ct, lds); }); return; }
  if (s == 1) {
    for_rows(sc, b, true, 16, [&](int rt, int c) { const int ch = rt * 2 + (c >> 3), h = (c >> 1) & 3;
      if (c & 1) glaprep_body<1>(p, l, ch, h, lds); else glaprep_body<0>(p, l, ch, h, lds); });
    return;
  }
  if (s == 2) {
    const bf16_t* PS = (const bf16_t*)(p.ws + O_R2); bf16_t* OSW = (bf16_t*)(p.ws + O_OSW);
    for (int it = bid; it < 512; it += nblk) { const int grp = it & 7, sl = (it >> 3) & 7, dir = (it >> 6) & 1, h = it >> 7;
      if (dir) gla_body<1, 0>(p, h, sl, grp, lds); else gla_body<0, 0>(p, h, sl, grp, lds); }
    for_rows(sc, b, wctx, 8, [&](int qt, int h) {
      if (qt < 128) {
        const int bb0 = max(0, qt * 2 - 2), bb1 = min(256, qt * 2 + 4);
        attn_item<128, true>(PS + h * 128, 1536, PS + 1024 + (h >> 2) * 128, 1536, PS + 1280 + (h >> 2) * 128, 1536, OSW + h * 128, 1024,
                             qt * 128, 256, 260, bb0, bb1, 0.08838834764831845f, true, p.swa_sink[l * 8 + h], lds);
      } else {
        attn_item<128, false>(PS + h * 128, 1536, PS + 1024 + (h >> 2) * 128, 1536, PS + 1280 + (h >> 2) * 128, 1536, OSW + h * 128, 1024,
                              qt * 128, 256, 260, 0, 0, 0.08838834764831845f, true, p.swa_sink[l * 8 + h], lds);
      }
    });
    return;
  }
  if (s == 3) {
    for_rows(sc, b, true, 44, [&](int rt, int c) {
      if (c < 12) mlaq_item(p, l, rt, c, lds);
      else if (c < 28) mlakv_item(p, l, rt, c - 12, lds);
      else if (c < 36) glapost_item(p, l, rt * 8 + (c - 28));
      else krdup_item(p, rt * 8 + (c - 36));
    });
    return;
  }
  if (s == 4) {
    const bf16_t* Qm = (const bf16_t*)(p.ws + O_R1); const bf16_t* Km = (const bf16_t*)(p.ws + O_KM); const bf16_t* Vm = (const bf16_t*)(p.ws + O_VM);
    bf16_t* OML = (bf16_t*)(p.ws + O_R2);
    for_rows(sc, b, wctx, 8, [&](int qt, int h) {
      if (qt < 128) attn_item<192, false>(Qm + h * 192, 1536, Km + h * 192, 1536, Vm + h * 128, 1024, OML + h * 128, 1024, qt * 128, 0, 260, 0, 0, 0.07216878364870323f, false, 0.f, lds);
      else attn_item<192, false>(Qm + h * 192, 1536, Km + h * 192, 1536, Vm + h * 128, 1024, OML + h * 128, 1024, qt * 128, 256, 260, 0, 0, 0.07216878364870323f, false, 0.f, lds);
    });
    return;
  }
  if (s == 5) { for_rows(sc, b, wctx, 8, [&](int rt, int ct) { merge_item(p, l, b, rt, ct, lds); }); return; }
  for_rows(sc, b, wctx, 8, [&](int rt, int ct) {
    const int lr0 = rt * 128; const long g0 = grow_of(b, lr0);
    const float* xs; float* xd;
    if (g0 < NLAT) { xs = ((l == 0) ? p.x : p.out) + g0 * DM; xd = p.out + g0 * DM; }
    else { xs = ((l == 0) ? p.ctx : Xc) + (g0 - NLAT) * DM; xd = Xc + (g0 - NLAT) * DM; }
    const int v = (g0 < NLAT) ? b : 2;
    resid_item((const bf16_t*)(p.ws + O_R1) + (long)lr0 * 1024, 1024, W + W_O, 1024, modl + v * 6144 + 2048, xs, xd, ct, lds);
  });
}

DI void grid_barrier(unsigned* ctr, unsigned target, bool heavy) {
  asm volatile("s_waitcnt vmcnt(0) lgkmcnt(0)" ::: "memory");
  __syncthreads();
  if (threadIdx.x == 0) {
    if (heavy) {
      __builtin_amdgcn_fence(__ATOMIC_RELEASE, "agent");
      asm volatile("s_waitcnt vmcnt(0) lgkmcnt(0)" ::: "memory");
    }
    __hip_atomic_fetch_add(ctr, 1u, __ATOMIC_RELAXED, __HIP_MEMORY_SCOPE_AGENT);
    while (__hip_atomic_load(ctr, __ATOMIC_RELAXED, __HIP_MEMORY_SCOPE_AGENT) < target) __builtin_amdgcn_s_sleep(1);
    __builtin_amdgcn_fence(__ATOMIC_ACQUIRE, "agent");
    asm volatile("s_waitcnt vmcnt(0) lgkmcnt(0)" ::: "memory");
  }
  __syncthreads();
}

__global__ void __launch_bounds__(256, 2) mega(Params p, int ph_lo, int ph_hi, int coop) {
  extern __shared__ __attribute__((aligned(16))) char lds[];
  unsigned* bar = (unsigned*)(p.ws + O_BAR);
  unsigned nbar = 0;
  Sched sc;
  const int xcc = (int)(__builtin_amdgcn_s_getreg((3 << 11) | 20) & 7u);
  sc.x = 0; sc.nx = 1;
  {
    int* sh = (int*)lds;
    if (threadIdx.x == 0) sh[0] = (int)__hip_atomic_fetch_add(bar + 64 + 16 * xcc, 1u, __ATOMIC_RELAXED, __HIP_MEMORY_SCOPE_AGENT);
    __syncthreads();
    sc.j = __builtin_amdgcn_readfirstlane(sh[0]);
    __syncthreads();
  }
  sc.nj = 1 << 30;
  if (coop) cg::this_grid().sync();
  {
    __builtin_amdgcn_fence(__ATOMIC_ACQUIRE, "");
    asm volatile("s_waitcnt vmcnt(0) lgkmcnt(0)" ::: "memory");
  }
  for (int ph = ph_lo; ph < ph_hi; ++ph) {
    if (ph > ph_lo && coop) {
      ++nbar;
      bool heavy = true;
      if (ph > 1) {
        const int q_ = (ph - 1) % 20;
        if (ph == N_PHASES - 1 || q_ == 0 || q_ >= 17) heavy = false;
        else { const int s_ = (q_ - 1) % 8; heavy = (s_ >= 2 && s_ <= 5); }
      }
      grid_barrier(bar, nbar * gridDim.x, heavy);
      if (ph == ph_lo + 1) {
        int nx = 0, xr = 0;
#pragma unroll
        for (int i = 0; i < 8; ++i) {
          const int cnt = (int)__hip_atomic_load(bar + 64 + 16 * i, __ATOMIC_RELAXED, __HIP_MEMORY_SCOPE_AGENT);
          if (cnt > 0) { ++nx; if (i < xcc) ++xr; }
          if (i == xcc) sc.nj = cnt;
        }
        sc.nx = __builtin_amdgcn_readfirstlane(nx); sc.x = __builtin_amdgcn_readfirstlane(xr); sc.nj = __builtin_amdgcn_readfirstlane(sc.nj);
      }
    }
    int reps_ = 1;
#ifdef PROBE_REP
    { const int q_ = (ph >= 1 && ph < N_PHASES - 1) ? (ph - 1) % 18 : -1; const int s_ = (q_ >= 1 && q_ < 15) ? (q_ - 1) % 7 : -1;
      if (PROBE_REP(q_, s_, ph)) reps_ = 2; }
#endif
#pragma unroll 1
    for (int r_ = 0; r_ < reps_; ++r_) run_phase(p, sc, ph, lds);
  }
}

extern "C" void kernel_launch(void* const* d_in, const int* in_sizes, int n_in, void* d_out, int out_size, void* d_ws, size_t ws_size,
                              hipStream_t stream) {
  static int grid_blocks = 0;
  if (!grid_blocks) {
    (void)hipFuncSetAttribute((const void*)mega, hipFuncAttributeMaxDynamicSharedMemorySize, LDS_BYTES);
    int dev = 0, cus = 0, per_cu = 0;
    (void)hipGetDevice(&dev);
    (void)hipDeviceGetAttribute(&cus, hipDeviceAttributeMultiprocessorCount, dev);
    (void)hipOccupancyMaxActiveBlocksPerMultiprocessor(&per_cu, mega, 256, LDS_BYTES);
    if (per_cu > 2) per_cu = 2;
    if (per_cu < 1) per_cu = 1;
    grid_blocks = cus * per_cu;
    if (ws_size < O_END2) fprintf(stderr, "workspace too small: %zu < %zu\n", ws_size, (size_t)O_END);
  }
  (void)hipMemsetAsync((char*)d_ws + O_BAR, 0, 1024, stream);
  Params p{};
  const float** pp = (const float**)&p;
  for (int i = 0; i < 22; ++i) pp[i] = (const float*)d_in[i];
  p.out = (float*)d_out; p.ws = (char*)d_ws;
  int lo = 0, hi = N_PHASES, coop = 1;
  void* args[] = {&p, &lo, &hi, &coop};
  hipError_t e = hipLaunchCooperativeKernel((const void*)mega, dim3(grid_blocks), dim3(256), args, LDS_BYTES, stream);
  if (e != hipSuccess) fprintf(stderr, "cooperative launch failed: %s (grid %d)\n", hipGetErrorString(e), grid_blocks);
}
```

```cpp
#include <hip/hip_runtime.h>
#include <hip/hip_cooperative_groups.h>
#include <cstdio>
#include <cstdint>
namespace cg = cooperative_groups;

typedef unsigned short bf16_t;
using bf16x8 = __attribute__((ext_vector_type(8))) short;
using s16x4  = __attribute__((ext_vector_type(4))) short;
using f32x4  = __attribute__((ext_vector_type(4))) float;
using f32x16 = __attribute__((ext_vector_type(16))) float;
using u32x4  = __attribute__((ext_vector_type(4))) unsigned;
using u32x2  = __attribute__((ext_vector_type(2))) unsigned;
#define DI __device__ __forceinline__
#define SBAR() __builtin_amdgcn_sched_barrier(0)
__device__ __forceinline__ int tid_opaque() { int t = threadIdx.x; asm volatile("" : "+v"(t)); return t; }

constexpr int DM = 1024, NB = 2, SEQ = 16384, CTX = 256, DEPTH = 2;
constexpr int TB = SEQ + CTX;
constexpr int TALL = NB * TB;
constexpr int NLAT = NB * SEQ;
constexpr int INW = 8416;
constexpr int NIN = 5376;
constexpr float EPS = 1e-6f;
constexpr float LOG2E = 1.4426950408889634f;

constexpr long W_IN = 0;
constexpr long W_G  = W_IN + (long)NIN * 1024;
constexpr long W_UQ = W_G + 3072L * 1024;
constexpr long W_UKV = W_UQ + 1536L * 384;
constexpr long W_B  = W_UKV + 2048L * 256;
constexpr long W_O  = W_B + 3L * 1024 * 1024;
constexpr long W_1  = W_O + 1024L * 1024;
constexpr long W_2  = W_1 + 4096L * 1024;
constexpr long W_LAYER = W_2 + 1024L * 4096;

constexpr size_t al256(size_t x) { return (x + 255) / 256 * 256; }
constexpr size_t O_W    = 0;
constexpr size_t O_MOD  = al256(O_W + (size_t)DEPTH * W_LAYER * 2);
constexpr size_t O_RSWA = al256(O_MOD + (size_t)DEPTH * 3 * 6144 * 4);
constexpr size_t O_RMLA = al256(O_RSWA + 256 * 32 * 8);
constexpr size_t O_BAR  = al256(O_RMLA + 256 * 16 * 8);
constexpr size_t O_GT   = al256(O_BAR + 1024);
constexpr size_t O_XC   = al256(O_GT + 2 * 260 * 512 * 4);
constexpr size_t O_H    = al256(O_XC + (size_t)NB * CTX * DM * 4);
constexpr size_t O_M    = al256(O_H + (size_t)TALL * DM * 2);
constexpr size_t O_R1   = O_M;
constexpr size_t O_R2   = al256(O_R1 + (size_t)TB * 2048 * 2);
constexpr size_t O_PR   = al256(O_R2 + (size_t)TB * 1536 * 2);
constexpr size_t O_PZ   = al256(O_PR + (size_t)TB * 1024 * 2);
constexpr size_t O_PM   = al256(O_PZ + (size_t)TB * 32 * 2);
constexpr size_t O_KM   = al256(O_PM + (size_t)TB * 704 * 2);
constexpr size_t O_VM   = al256(O_KM + (size_t)TB * 1536 * 2);
constexpr size_t O_OF   = al256(O_VM + (size_t)TB * 1024 * 2);
constexpr size_t O_OB   = al256(O_OF + (size_t)TB * 1024 * 2);
constexpr size_t O_OSW  = al256(O_OB + (size_t)TB * 1024 * 2);
constexpr size_t O_END  = al256(O_OSW + (size_t)TB * 1024 * 2);
constexpr size_t O_SE   = O_END;
constexpr size_t O_GTOT = al256(O_SE + 512ull * 4096 * 4);
constexpr size_t O_END2 = al256(O_GTOT + 512ull * 128 * 4);
constexpr size_t O_U    = O_M;
static_assert(O_U + (size_t)TALL * 4096 * 2 <= O_END, "U must fit in mixer region");

constexpr int LDS_BYTES = 65536;

struct Params {
  const float *x, *c, *ctx, *c_ctx, *ada_w, *ada_b, *norm_mix_w, *w_in, *gla_a_w, *gla_a_b, *gla_norm_w, *swa_sink,
      *mla_q_norm_w, *mla_w_uq, *mla_kv_norm_w, *mla_w_ukv, *w_branch, *w_out, *norm_mlp_w, *mlp_w1, *mlp_w2, *final_norm_w;
  float* out;
  char* ws;
};

typedef __bf16 bf16x2_t __attribute__((ext_vector_type(2)));
typedef float float2_t __attribute__((ext_vector_type(2)));
DI unsigned cvtpk(float lo, float hi) { float2_t f = {lo, hi}; bf16x2_t r = __builtin_convertvector(f, bf16x2_t); return __builtin_bit_cast(unsigned, r); }
DI bf16_t f2bf(float x) { return (bf16_t)(cvtpk(x, x) & 0xffffu); }
DI float bf2f(bf16_t v) { return __uint_as_float(((unsigned)v) << 16); }
DI float bflo(unsigned u) { return __uint_as_float(u << 16); }
DI float bfhi(unsigned u) { return __uint_as_float(u & 0xffff0000u); }
DI float wave_sum(float v) {
  v += __shfl_xor(v, 32); v += __shfl_xor(v, 16); v += __shfl_xor(v, 8); v += __shfl_xor(v, 4); v += __shfl_xor(v, 2); v += __shfl_xor(v, 1);
  return v;
}
DI int crow(int r, int hi) { return (r & 3) + 8 * (r >> 2) + 4 * hi; }
DI float sigmoidf_(float x) { return 1.f / (1.f + __expf(-x)); }
DI long grow_of(int b, int lr) { return lr < SEQ ? (long)b * SEQ + lr : (long)NLAT + b * CTX + (lr - SEQ); }
#define MFMA16(a, b, c) __builtin_amdgcn_mfma_f32_16x16x32_bf16((a), (b), (c), 0, 0, 0)
#define MFMA32(a, b, c) __builtin_amdgcn_mfma_f32_32x32x16_bf16((a), (b), (c), 0, 0, 0)

DI void conv_tile(const float* __restrict__ src, int ld_src, bf16_t* __restrict__ dst, int K, int n0, int k0, int kind,
                  const float* __restrict__ kscale, float* lds) {
  const int tid = tid_opaque();
  {
    const int nn = tid & 63; const int n = n0 + nn;
    int sc = n; float s = 1.f;
    if (kind == 1) {
      if (n < 3072) { sc = n; s = (n < 512) ? 0.08838834764831845f : 1.f; }
      else if (n < 5312) sc = n + 32;
      else if (n < 5344) sc = n - 5312 + 3072;
      else sc = -1;
    } else if (kind == 2) sc = 5344 + n;
#pragma unroll
    for (int i = 0; i < 16; ++i) {
      const int kk = (tid >> 6) + 4 * i;
      float v = 0.f;
      if (sc >= 0) { v = src[(long)(k0 + kk) * ld_src + sc] * s; if (kscale) v *= kscale[k0 + kk]; }
      lds[kk * 65 + nn] = v;
    }
  }
  __syncthreads();
  {
    const int kk2 = (tid & 31) * 2;
#pragma unroll
    for (int i = 0; i < 8; ++i) {
      const int n = (tid >> 5) + 8 * i;
      const float a = lds[kk2 * 65 + n], b = lds[(kk2 + 1) * 65 + n];
      *(unsigned*)&dst[(long)(n0 + n) * K + k0 + kk2] = cvtpk(a, b);
    }
  }
  __syncthreads();
}

constexpr int CONV_PER_LAYER = 1344 + 768 + 144 + 128 + 768 + 256 + 1024 + 1024;
DI void conv_item(const Params& p, int it, char* lds) {
  const int l = it / CONV_PER_LAYER; int t = it % CONV_PER_LAYER;
  bf16_t* W = (bf16_t*)(p.ws + O_W) + (long)l * W_LAYER;
  float* f = (float*)lds;
  if (t < 1344) { conv_tile(p.w_in + (long)l * 1024 * INW, INW, W + W_IN, 1024, (t / 16) * 64, (t % 16) * 64, 1, nullptr, f); return; }
  t -= 1344;
  if (t < 768) { conv_tile(p.w_in + (long)l * 1024 * INW, INW, W + W_G, 1024, (t / 16) * 64, (t % 16) * 64, 2, nullptr, f); return; }
  t -= 768;
  if (t < 144) { conv_tile(p.mla_w_uq + (long)l * 384 * 1536, 1536, W + W_UQ, 384, (t / 6) * 64, (t % 6) * 64, 0, p.mla_q_norm_w + l * 384, f); return; }
  t -= 144;
  if (t < 128) { conv_tile(p.mla_w_ukv + (long)l * 256 * 2048, 2048, W + W_UKV, 256, (t / 4) * 64, (t % 4) * 64, 0, p.mla_kv_norm_w + l * 256, f); return; }
  t -= 128;
  if (t < 768) { const int i = t / 256, tt = t % 256;
    conv_tile(p.w_branch + ((long)l * 3 + i) * 1024 * 1024, 1024, W + W_B + (long)i * 1024 * 1024, 1024, (tt / 16) * 64, (tt % 16) * 64, 0, nullptr, f); return; }
  t -= 768;
  if (t < 256) { conv_tile(p.w_out + (long)l * 1024 * 1024, 1024, W + W_O, 1024, (t / 16) * 64, (t % 16) * 64, 0, nullptr, f); return; }
  t -= 256;
  if (t < 1024) { conv_tile(p.mlp_w1 + (long)l * 1024 * 4096, 4096, W + W_1, 1024, (t / 16) * 64, (t % 16) * 64, 0, nullptr, f); return; }
  t -= 1024;
  conv_tile(p.mlp_w2 + (long)l * 4096 * 1024, 1024, W + W_2, 4096, (t / 64) * 64, (t % 64) * 64, 0, nullptr, f);
}

DI void adaln_item(const Params& p, int it, char* lds) {
  const int l = it / 96, cb = it % 96, tid = tid_opaque();
  float* sv = (float*)lds;
  float* red = sv + 3072;
  for (int i = tid; i < 3072; i += 256) {
    const int v = i >> 10, k = i & 1023;
    const float x = (v < 2) ? p.c[v * 1024 + k] : p.c_ctx[k];
    sv[i] = x / (1.f + __expf(-x));
  }
  __syncthreads();
  const int col = tid & 63, kq = tid >> 6;
  const float* w = p.ada_w + (long)l * 1024 * 6144 + cb * 64 + col;
  float a0 = 0, a1 = 0, a2 = 0;
#pragma unroll 8
  for (int k = kq * 256; k < kq * 256 + 256; ++k) {
    const float wv = w[(long)k * 6144];
    a0 += sv[k] * wv; a1 += sv[1024 + k] * wv; a2 += sv[2048 + k] * wv;
  }
  red[(kq * 3 + 0) * 64 + col] = a0; red[(kq * 3 + 1) * 64 + col] = a1; red[(kq * 3 + 2) * 64 + col] = a2;
  __syncthreads();
  if (tid < 192) {
    const int v = tid >> 6, cc = tid & 63;
    const float s = red[(0 * 3 + v) * 64 + cc] + red[(1 * 3 + v) * 64 + cc] + red[(2 * 3 + v) * 64 + cc] + red[(3 * 3 + v) * 64 + cc];
    float* mod = (float*)(p.ws + O_MOD);
    mod[((long)l * 3 + v) * 6144 + cb * 64 + cc] = s + p.ada_b[l * 6144 + cb * 64 + cc];
  }
  __syncthreads();
}

DI void rope_item(const Params& p) {
  const int pos = tid_opaque();
  float2* ts = (float2*)(p.ws + O_RSWA); float2* tm = (float2*)(p.ws + O_RMLA);
  for (int i = 0; i < 32; ++i) {
    const float inv = exp2f(-(float)i * (13.287712379549449f / 32.f));
    const float ang = (float)pos * inv;
    const double rev = (double)ang * 0.15915494309189535; const float fr = (float)(rev - floor(rev));
    ts[pos * 32 + i] = make_float2(__builtin_amdgcn_cosf(fr), __builtin_amdgcn_sinf(fr));
  }
  for (int i = 0; i < 16; ++i) {
    const float inv = exp2f(-(float)i * (13.287712379549449f / 16.f));
    const float ang = (float)pos * inv;
    const double rev = (double)ang * 0.15915494309189535; const float fr = (float)(rev - floor(rev));
    tm[pos * 16 + i] = make_float2(__builtin_amdgcn_cosf(fr), __builtin_amdgcn_sinf(fr));
  }
}

DI void normmod_item(const float* __restrict__ xl, const float* __restrict__ xc, const float* __restrict__ w, const float* __restrict__ modl,
                     int shift_off, int scale_off, bf16_t* __restrict__ H, int it) {
  const int lane = tid_opaque() & 63, wid = tid_opaque() >> 6;
#pragma unroll 1
  for (int rr = 0; rr < 4; ++rr) {
    const long g = (long)it * 16 + wid * 4 + rr;
    const float* src = (g < NLAT) ? xl + g * DM : xc + (g - NLAT) * DM;
    const int v = (g < NLAT) ? (int)(g >> 14) : 2;
    float4 xv[4]; float ss = 0;
#pragma unroll
    for (int i = 0; i < 4; ++i) { xv[i] = *(const float4*)(src + i * 256 + lane * 4); ss += xv[i].x * xv[i].x + xv[i].y * xv[i].y + xv[i].z * xv[i].z + xv[i].w * xv[i].w; }
    ss = wave_sum(ss);
    const float rinv = rsqrtf(ss * (1.f / DM) + EPS);
    const float* sh = modl + v * 6144 + shift_off; const float* sc = modl + v * 6144 + scale_off;
#pragma unroll
    for (int i = 0; i < 4; ++i) {
      const int e = i * 256 + lane * 4;
      const float4 wv = *(const float4*)(w + e), s4 = *(const float4*)(sc + e), h4 = *(const float4*)(sh + e);
      const float y0 = xv[i].x * rinv * wv.x * (1.f + s4.x) + h4.x, y1 = xv[i].y * rinv * wv.y * (1.f + s4.y) + h4.y;
      const float y2 = xv[i].z * rinv * wv.z * (1.f + s4.z) + h4.z, y3 = xv[i].w * rinv * wv.w * (1.f + s4.w) + h4.w;
      u32x2 o = {cvtpk(y0, y1), cvtpk(y2, y3)};
      *(u32x2*)(H + g * DM + e) = o;
    }
  }
}
DI void finalnorm_item(float* __restrict__ x, const float* __restrict__ w, int it) {
  const int lane = tid_opaque() & 63, wid = tid_opaque() >> 6;
#pragma unroll 1
  for (int rr = 0; rr < 4; ++rr) {
    const long g = (long)it * 16 + wid * 4 + rr;
    float* src = x + g * DM;
    float4 xv[4]; float ss = 0;
#pragma unroll
    for (int i = 0; i < 4; ++i) { xv[i] = *(const float4*)(src + i * 256 + lane * 4); ss += xv[i].x * xv[i].x + xv[i].y * xv[i].y + xv[i].z * xv[i].z + xv[i].w * xv[i].w; }
    ss = wave_sum(ss);
    const float rinv = rsqrtf(ss * (1.f / DM) + EPS);
#pragma unroll
    for (int i = 0; i < 4; ++i) {
      const int e = i * 256 + lane * 4;
      const float4 wv = *(const float4*)(w + e);
      float4 o; o.x = xv[i].x * rinv * wv.x; o.y = xv[i].y * rinv * wv.y; o.z = xv[i].z * rinv * wv.z; o.w = xv[i].w * rinv * wv.w;
      *(float4*)(src + e) = o;
    }
  }
}

template <int NT, bool ROWSS, bool ZERO = true>
DI void gemm_core(const bf16_t* __restrict__ A, long lda, const bf16_t* __restrict__ Bt, long ldb, int K, f32x4 (&acc)[4][NT], char* lds) {
  constexpr int BROWS = NT * 32, STAGE = 16384 + BROWS * 128;
  const int tid = tid_opaque(), lane = tid & 63, wid = tid >> 6, fr = lane & 15, fq = lane >> 4, wr = wid >> 1, wc = wid & 1;
  const int lrow = tid >> 3, lch = tid & 7;
  const bf16_t* ap = A + (long)lrow * lda + lch * 8;
  const bf16_t* bp = Bt + (long)lrow * ldb + lch * 8;
  const int woff = lrow * 128 + ((lch ^ ((lrow >> 1) & 7)) << 4);
  bf16x8 ra[4], rb[NT];
  float ss[4] = {0.f, 0.f, 0.f, 0.f};
  if (ZERO) {
#pragma unroll
    for (int m = 0; m < 4; ++m)
#pragma unroll
      for (int n = 0; n < NT; ++n) acc[m][n] = f32x4{0.f, 0.f, 0.f, 0.f};
  }
  __syncthreads();
#pragma unroll
  for (int i = 0; i < 4; ++i) ra[i] = *(const bf16x8*)(ap + (long)i * 32 * lda);
#pragma unroll
  for (int i = 0; i < NT; ++i) rb[i] = *(const bf16x8*)(bp + (long)i * 32 * ldb);
#pragma unroll
  for (int i = 0; i < 4; ++i) *(bf16x8*)(lds + woff + i * 4096) = ra[i];
#pragma unroll
  for (int i = 0; i < NT; ++i) *(bf16x8*)(lds + 16384 + woff + i * 4096) = rb[i];
  if (ROWSS) {
#pragma unroll
    for (int i = 0; i < 4; ++i)
#pragma unroll
      for (int j = 0; j < 8; ++j) { const float f = bf2f((bf16_t)ra[i][j]); ss[i] += f * f; }
  }
  __syncthreads();
  const int nk = K / 64;
  const int sw = fr >> 1;
#pragma unroll 1
  for (int kt = 0; kt < nk; ++kt) {
    const char* sA = lds + (kt & 1) * STAGE; const char* sB = sA + 16384;
    const bool more = (kt + 1 < nk);
    if (more) {
      const int k0 = (kt + 1) * 64;
#pragma unroll
      for (int i = 0; i < 4; ++i) ra[i] = *(const bf16x8*)(ap + (long)i * 32 * lda + k0);
#pragma unroll
      for (int i = 0; i < NT; ++i) rb[i] = *(const bf16x8*)(bp + (long)i * 32 * ldb + k0);
    }
#pragma unroll
    for (int kk = 0; kk < 2; ++kk) {
      bf16x8 af[4], bfr[NT];
      const int ch = ((kk * 4 + fq) ^ sw) << 4;
#pragma unroll
      for (int m = 0; m < 4; ++m) af[m] = *(const bf16x8*)(sA + (wr * 64 + m * 16 + fr) * 128 + ch);
#pragma unroll
      for (int n = 0; n < NT; ++n) bfr[n] = *(const bf16x8*)(sB + (wc * NT * 16 + n * 16 + fr) * 128 + ch);
#pragma unroll
      for (int m = 0; m < 4; ++m)
#pragma unroll
        for (int n = 0; n < NT; ++n) acc[m][n] = MFMA16(af[m], bfr[n], acc[m][n]);
    }
    if (more) {
      char* d = lds + ((kt + 1) & 1) * STAGE;
#pragma unroll
      for (int i = 0; i < 4; ++i) *(bf16x8*)(d + woff + i * 4096) = ra[i];
#pragma unroll
      for (int i = 0; i < NT; ++i) *(bf16x8*)(d + 16384 + woff + i * 4096) = rb[i];
      if (ROWSS) {
#pragma unroll
        for (int i = 0; i < 4; ++i)
#pragma unroll
          for (int j = 0; j < 8; ++j) { const float f = bf2f((bf16_t)ra[i][j]); ss[i] += f * f; }
      }
    }
    __syncthreads();
  }
  if (ROWSS) {
    float* rss = (float*)lds;
#pragma unroll
    for (int i = 0; i < 4; ++i) {
      float v = ss[i]; v += __shfl_xor(v, 1); v += __shfl_xor(v, 2); v += __shfl_xor(v, 4);
      if (lch == 0) rss[lrow + 32 * i] = v;
    }
    __syncthreads();
  }
}

#define ROT(X1, X2, CS) do { const float2 cs_ = (CS); const float a_ = (X1) * cs_.x - (X2) * cs_.y, b_ = (X2) * cs_.x + (X1) * cs_.y; (X1) = a_; (X2) = b_; } while (0)

DI void inproj_item(const Params& p, int l, int b, int rt, int ct, char* lds) {
  const bf16_t* W = (const bf16_t*)(p.ws + O_W) + (long)l * W_LAYER + W_IN;
  const bf16_t* H = (const bf16_t*)(p.ws + O_H);
  const int lr0 = rt * 128;
  f32x4 acc[4][4];
  gemm_core<4, false>(H + grow_of(b, lr0) * DM, DM, W + (long)ct * 128 * 1024, 1024, 1024, acc, lds);
  const int lane = tid_opaque() & 63, wid = tid_opaque() >> 6, fr = lane & 15, fq = lane >> 4, wr = wid >> 1, wc = wid & 1;
  const int c0 = ct * 128 + wc * 64;
  const int rbase = lr0 + wr * 64 + fq * 4;
  const bool latent = lr0 < SEQ;
  bf16_t* dst; int ld, cc;
  int ropek = 0;
  bool ropecol = false;
  if (c0 < 2048) { dst = (bf16_t*)(p.ws + O_R1); ld = 2048; cc = c0; }
  else if (c0 < 3072) { dst = (bf16_t*)(p.ws + O_PR); ld = 1024; cc = c0 - 2048; }
  else if (c0 < 4608) { dst = (bf16_t*)(p.ws + O_R2); ld = 1536; cc = c0 - 3072; if (cc < 1280 && latent) { ropek = 1; ropecol = (cc >> 6) & 1; } }
  else if (c0 < 5312) { dst = (bf16_t*)(p.ws + O_PM); ld = 704; cc = c0 - 4608; if (cc == 640 && latent) ropek = 2; }
  else { dst = (bf16_t*)(p.ws + O_PZ); ld = 32; cc = 0; }
  if (ropek == 1) {
    const float2* tab = (const float2*)(p.ws + O_RSWA);
#pragma unroll
    for (int m = 0; m < 4; ++m)
#pragma unroll
      for (int j = 0; j < 4; ++j) {
        const int t = rbase + m * 16 + j; const int pos = ropecol ? (t & 63) : (t >> 6);
#pragma unroll
        for (int n = 0; n < 2; ++n) ROT(acc[m][n][j], acc[m][n + 2][j], tab[pos * 32 + n * 16 + fr]);
      }
  } else if (ropek == 2) {
    const float2* tab = (const float2*)(p.ws + O_RMLA);
#pragma unroll
    for (int m = 0; m < 4; ++m)
#pragma unroll
      for (int j = 0; j < 4; ++j) {
        const int t = rbase + m * 16 + j;
        ROT(acc[m][0][j], acc[m][1][j], tab[(t >> 6) * 16 + fr]);
        ROT(acc[m][2][j], acc[m][3][j], tab[(t & 63) * 16 + fr]);
      }
  }
  const bool isz = (c0 >= 5312);
#pragma unroll
  for (int m = 0; m < 4; ++m)
#pragma unroll
    for (int n = 0; n < 4; ++n) {
      if (isz && n >= 2) continue;
#pragma unroll
      for (int j = 0; j < 4; ++j) dst[(long)(rbase + m * 16 + j) * ld + cc + n * 16 + fr] = f2bf(acc[m][n][j]);
    }
}

DI void mlaq_item(const Params& p, int l, int rt, int ct, char* lds) {
  const bf16_t* W = (const bf16_t*)(p.ws + O_W) + (long)l * W_LAYER + W_UQ;
  const bf16_t* PM = (const bf16_t*)(p.ws + O_PM);
  bf16_t* Qm = (bf16_t*)(p.ws + O_R1);
  const int lr0 = rt * 128;
  f32x4 acc[4][4];
  gemm_core<4, true>(PM + (long)lr0 * 704, 704, W + (long)ct * 128 * 384, 384, 384, acc, lds);
  const float* rss = (const float*)lds;
  const int lane = tid_opaque() & 63, wid = tid_opaque() >> 6, fr = lane & 15, fq = lane >> 4, wr = wid >> 1, wc = wid & 1;
  const int c0 = ct * 128 + wc * 64;
  const int rl = wr * 64 + fq * 4;
  const bool isrope = ((c0 >> 6) % 3) == 2 && lr0 < SEQ;
  const float2* tab = (const float2*)(p.ws + O_RMLA);
#pragma unroll
  for (int m = 0; m < 4; ++m)
#pragma unroll
    for (int j = 0; j < 4; ++j) {
      const int rloc = rl + m * 16 + j; const int t = lr0 + rloc;
      const float rinv = rsqrtf(rss[rloc] * (1.f / 384.f) + EPS);
      float v0 = acc[m][0][j] * rinv, v1 = acc[m][1][j] * rinv, v2 = acc[m][2][j] * rinv, v3 = acc[m][3][j] * rinv;
      if (isrope) { ROT(v0, v1, tab[(t >> 6) * 16 + fr]); ROT(v2, v3, tab[(t & 63) * 16 + fr]); }
      bf16_t* d = Qm + (long)t * 1536 + c0 + fr;
      d[0] = f2bf(v0); d[16] = f2bf(v1); d[32] = f2bf(v2); d[48] = f2bf(v3);
    }
}
DI void mlakv_item(const Params& p, int l, int rt, int ct, char* lds) {
  const bf16_t* W = (const bf16_t*)(p.ws + O_W) + (long)l * W_LAYER + W_UKV;
  const bf16_t* PM = (const bf16_t*)(p.ws + O_PM);
  bf16_t* Km = (bf16_t*)(p.ws + O_KM); bf16_t* Vm = (bf16_t*)(p.ws + O_VM);
  const int lr0 = rt * 128;
  f32x4 acc[4][4];
  gemm_core<4, true>(PM + (long)lr0 * 704 + 384, 704, W + (long)ct * 128 * 256, 256, 256, acc, lds);
  const float* rss = (const float*)lds;
  const int lane = tid_opaque() & 63, wid = tid_opaque() >> 6, fr = lane & 15, fq = lane >> 4, wr = wid >> 1, wc = wid & 1;
  const int c0 = ct * 128 + wc * 64;
  const int head = c0 >> 8, within = c0 & 255;
  const int rl = wr * 64 + fq * 4;
  bf16_t* dst; int ld;
  if (within < 128) { dst = Km + head * 192 + within; ld = 1536; } else { dst = Vm + head * 128 + (within - 128); ld = 1024; }
#pragma unroll
  for (int m = 0; m < 4; ++m)
#pragma unroll
    for (int j = 0; j < 4; ++j) {
      const int rloc = rl + m * 16 + j; const int t = lr0 + rloc;
      const float rinv = rsqrtf(rss[rloc] * (1.f / 256.f) + EPS);
      bf16_t* d = dst + (long)t * ld + fr;
#pragma unroll
      for (int n = 0; n < 4; ++n) d[n * 16] = f2bf(acc[m][n][j] * rinv);
    }
}
DI void krdup_item(const Params& p, int it) {
  const bf16_t* PM = (const bf16_t*)(p.ws + O_PM); bf16_t* Km = (bf16_t*)(p.ws + O_KM);
  const int tid = tid_opaque(); const int r = it * 16 + (tid >> 4); const int q = tid & 15;
  const int h = q >> 1, half = q & 1;
  const u32x4* s = (const u32x4*)(PM + (long)r * 704 + 640 + half * 32);
  u32x4* d = (u32x4*)(Km + (long)r * 1536 + h * 192 + 128 + half * 32);
#pragma unroll
  for (int i = 0; i < 4; ++i) d[i] = s[i];
}

DI void merge_item(const Params& p, int l, int b, int rt, int ct, char* lds) {
  const bf16_t* W = (const bf16_t*)(p.ws + O_W) + (long)l * W_LAYER;
  const bf16_t* H = (const bf16_t*)(p.ws + O_H);
  const int lr0 = rt * 128;
  const bf16_t* Hrow = H + grow_of(b, lr0) * DM;
  f32x4 tot[4][4], acc[4][4];
  unsigned gp[4][4][2];
#pragma unroll
  for (int m = 0; m < 4; ++m)
#pragma unroll
    for (int n = 0; n < 4; ++n) tot[m][n] = f32x4{0, 0, 0, 0};
#pragma unroll 1
  for (int i = 0; i < 3; ++i) {
    const bf16_t* O = (const bf16_t*)(p.ws + (i == 0 ? O_PR : (i == 1 ? O_OSW : O_R2)));
    gemm_core<4, false>(Hrow, DM, W + W_G + ((long)i * 1024 + ct * 128) * 1024, 1024, 1024, acc, lds);
#pragma unroll
    for (int m = 0; m < 4; ++m)
#pragma unroll
      for (int n = 0; n < 4; ++n) {
        float g0 = fmaxf(sigmoidf_(acc[m][n][0]), 1e-20f), g1 = fmaxf(sigmoidf_(acc[m][n][1]), 1e-20f);
        float g2 = fmaxf(sigmoidf_(acc[m][n][2]), 1e-20f), g3 = fmaxf(sigmoidf_(acc[m][n][3]), 1e-20f);
        gp[m][n][0] = cvtpk(g0, g1); gp[m][n][1] = cvtpk(g2, g3);
        tot[m][n][0] = tot[m][n][0] / bflo(gp[m][n][0]); tot[m][n][1] = tot[m][n][1] / bfhi(gp[m][n][0]);
        tot[m][n][2] = tot[m][n][2] / bflo(gp[m][n][1]); tot[m][n][3] = tot[m][n][3] / bfhi(gp[m][n][1]);
      }
    gemm_core<4, false, false>(O + (long)lr0 * 1024, 1024, W + W_B + ((long)i * 1024 + ct * 128) * 1024, 1024, 1024, tot, lds);
#pragma unroll
    for (int m = 0; m < 4; ++m)
#pragma unroll
      for (int n = 0; n < 4; ++n) {
        tot[m][n][0] *= bflo(gp[m][n][0]); tot[m][n][1] *= bfhi(gp[m][n][0]);
        tot[m][n][2] *= bflo(gp[m][n][1]); tot[m][n][3] *= bfhi(gp[m][n][1]);
      }
  }
  const int lane = tid_opaque() & 63, wid = tid_opaque() >> 6, fr = lane & 15, fq = lane >> 4, wr = wid >> 1, wc = wid & 1;
  bf16_t* Mg = (bf16_t*)(p.ws + O_R1);
#pragma unroll
  for (int m = 0; m < 4; ++m)
#pragma unroll
    for (int n = 0; n < 4; ++n)
#pragma unroll
      for (int j = 0; j < 4; ++j)
        Mg[(long)(lr0 + wr * 64 + m * 16 + fq * 4 + j) * 1024 + ct * 128 + wc * 64 + n * 16 + fr] = f2bf(tot[m][n][j]);
}

DI void resid_item(const bf16_t* A, long lda, const bf16_t* Bt, int K, const float* gate, const float* xsrc, float* xdst, int ct, char* lds) {
  f32x4 acc[4][4];
  gemm_core<4, false>(A, lda, Bt + (long)ct * 128 * K, K, K, acc, lds);
  const int lane = tid_opaque() & 63, wid = tid_opaque() >> 6, fr = lane & 15, fq = lane >> 4, wr = wid >> 1, wc = wid & 1;
#pragma unroll
  for (int n = 0; n < 4; ++n) {
    const int col = ct * 128 + wc * 64 + n * 16 + fr;
    const float gt = gate[col];
#pragma unroll
    for (int m = 0; m < 4; ++m)
#pragma unroll
      for (int j = 0; j < 4; ++j) {
        const long o = (long)(wr * 64 + m * 16 + fq * 4 + j) * DM + col;
        xdst[o] = xsrc[o] + gt * acc[m][n][j];
      }
  }
}
DI void mlp1_item(const Params& p, int l, int rt, int ct, char* lds) {
  const bf16_t* W = (const bf16_t*)(p.ws + O_W) + (long)l * W_LAYER + W_1;
  const bf16_t* H = (const bf16_t*)(p.ws + O_H);
  bf16_t* U = (bf16_t*)(p.ws + O_U);
  f32x4 acc[4][4];
  gemm_core<4, false>(H + (long)rt * 128 * DM, DM, W + (long)ct * 128 * 1024, 1024, 1024, acc, lds);
  const int lane = tid_opaque() & 63, wid = tid_opaque() >> 6, fr = lane & 15, fq = lane >> 4, wr = wid >> 1, wc = wid & 1;
#pragma unroll
  for (int m = 0; m < 4; ++m)
#pragma unroll
    for (int n = 0; n < 4; ++n)
#pragma unroll
      for (int j = 0; j < 4; ++j) {
        const float v = fmaxf(acc[m][n][j], 0.f);
        U[(long)(rt * 128 + wr * 64 + m * 16 + fq * 4 + j) * 4096 + ct * 128 + wc * 64 + n * 16 + fr] = f2bf(v * v);
      }
}

template <int DIR>
DI void glaprep_body(const Params& p, int l, int c, int h, char* lds) {
  const int tid = tid_opaque(), d = tid & 127, hf = tid >> 7;
  float* zs = (float*)lds;
  float* hs = zs + 1024;
  const bf16_t* PZ = (const bf16_t*)(p.ws + O_PZ);
  const bf16_t* PG = (const bf16_t*)(p.ws + O_R1);
  const int lr0 = c * 64;
  __syncthreads();
#pragma unroll
  for (int i = 0; i < 4; ++i) { const int e = tid + 256 * i; zs[e] = bf2f(PZ[(long)(lr0 + (e >> 4)) * 32 + DIR * 16 + (e & 15)]); }
  float aw[16];
  const float* awp = p.gla_a_w + ((long)(l * 2 + DIR) * 16) * 512 + h * 128 + d;
#pragma unroll
  for (int r = 0; r < 16; ++r) aw[r] = awp[r * 512];
  const float ab = p.gla_a_b[(l * 2 + DIR) * 512 + h * 128 + d];
  __syncthreads();
  float la[32]; float sum = 0.f;
#pragma unroll
  for (int ii = 0; ii < 32; ++ii) {
    const float* z = zs + (hf * 32 + ii) * 16;
    float x = ab;
#pragma unroll
    for (int r = 0; r < 16; ++r) x += z[r] * aw[r];
    const float ls = fminf(x, 0.f) - __logf(1.f + __expf(-fabsf(x)));
    la[ii] = ls * (1.f / 16.f); sum += la[ii];
  }
  hs[hf * 128 + d] = sum;
  __syncthreads();
  const float other = hs[(1 - hf) * 128 + d];
  const float total = sum + other;
  bf16_t* QD = (bf16_t*)(p.ws + (DIR ? O_VM : O_KM));
  bf16_t* KI = QD + (long)TB * 512;
  float run = (DIR == 0) ? (hf == 1 ? other : 0.f) : (hf == 0 ? other : 0.f);
#pragma unroll
  for (int s = 0; s < 32; ++s) {
    const int ii = (DIR == 0) ? s : 31 - s;
    run += la[ii];
    const long row = lr0 + hf * 32 + ii;
    const float q = bf2f(PG[row * 2048 + h * 128 + d]);
    const float k = bf2f(PG[row * 2048 + 512 + h * 128 + d]);
    const float e = __expf(run);
    QD[row * 512 + h * 128 + d] = f2bf(q * e);
    KI[row * 512 + h * 128 + d] = f2bf(k * __expf(-run));
  }
  if (hf == 0) ((float*)(p.ws + O_GT))[((long)DIR * 260 + c) * 512 + h * 128 + d] = __expf(total);
}

DI int swz256(int row, int cb) { return row * 256 + (cb ^ ((row & 7) << 4)); }
DI int v_st(int k, int c) { const int kk = (k & ~0xC) | ((k & 4) << 1) | ((k & 8) >> 1); return ((kk >> 3) * 4 + (c >> 5)) * 512 + ((kk & 7) * 32 + (c & 31)) * 2; }
DI int v_st32(int k, int c) { const int kk = (k & ~0xC) | ((k & 4) << 1) | ((k & 8) >> 1); return (kk >> 3) * 512 + ((kk & 7) * 32 + c) * 2; }
DI int v_rd_base(int lane) { return ((lane & 3) << 3) | (((lane >> 2) & 3) << 6) | (((lane >> 4) & 1) << 5) | (((lane >> 5) & 1) << 8); }
constexpr int v_rd_off(int d0, int ks, int half) { return d0 * 512 + ks * 4096 + half * 2048; }
typedef __attribute__((address_space(3))) s16x4* lds_v4p;
template <int OFF> DI s16x4 tr_read(int vb) { return __builtin_amdgcn_ds_read_tr16_b64_v4i16((lds_v4p)(unsigned)(vb + OFF)); }
#define PKF(L, H) (bf16x8){L[0], L[1], L[2], L[3], H[0], H[1], H[2], H[3]}
#define PK4(P, BASE, OUT) do { unsigned a0_ = cvtpk(P[BASE + 0], P[BASE + 1]), a1_ = cvtpk(P[BASE + 2], P[BASE + 3]);   \
    unsigned b0_ = cvtpk(P[BASE + 4], P[BASE + 5]), b1_ = cvtpk(P[BASE + 6], P[BASE + 7]);                              \
    auto r0_ = __builtin_amdgcn_permlane32_swap(a0_, b0_, false, false); auto r1_ = __builtin_amdgcn_permlane32_swap(a1_, b1_, false, false); \
    u32x4 w_ = {r0_[0], r1_[0], r0_[1], r1_[1]}; OUT = *reinterpret_cast<bf16x8*>(&w_); } while (0)

DI int gla_gs(int g) { return g <= 4 ? 33 * g : 132 + 32 * (g - 4); }
template <int DIR, int MODE>
DI void gla_body(const Params& p, int h, int sl, int grp, char* lds) {
  const int tid = tid_opaque(), lane = tid & 63, wid = tid >> 6, r32 = lane & 31, hi = lane >> 5;
  char* sQD = lds; char* sKI = lds + 16384; char* sKIv = lds + 32768; char* sV = lds + 49152; char* sST = lds + 53248;
  float* sG = (float*)(lds + 61952);
  const bf16_t* QD = (const bf16_t*)(p.ws + (DIR ? O_VM : O_KM)) + h * 128;
  const bf16_t* KI = QD + (long)TB * 512;
  const bf16_t* PV = (const bf16_t*)(p.ws + O_R1) + 1024 + h * 256 + sl * 32;
  const float* GT = (const float*)(p.ws + O_GT) + (long)DIR * 260 * 512 + h * 128;
  bf16_t* Oo = (bf16_t*)(p.ws + (DIR ? O_OB : O_OF)) + (long)(h * 8 + sl) * TB * 32;
  const int it0 = ((h * 2 + DIR) * 8 + sl) * 8;
  float* SE = (float*)(p.ws + O_SE); float* GTOT = (float*)(p.ws + O_GTOT);
  const int s_begin = gla_gs(grp), s_end = gla_gs(grp + 1);
  f32x16 S, gacc;
#pragma unroll
  for (int r = 0; r < 16; ++r) { S[r] = 0.f; gacc[r] = 1.f; }
  if (MODE == 1) {
    if (grp == 0) return;
    for (int g = 0; g < grp; ++g) {
      const float* se = SE + (long)(it0 + g) * 4096; const float* gt = GTOT + (long)(it0 + g) * 128;
#pragma unroll
      for (int r = 0; r < 16; ++r) { const int d = wid * 32 + crow(r, hi); S[r] = gt[d] * S[r] + se[d * 32 + r32]; }
    }
  }
  bf16x8 rq[4], rk[4], rv; float rg = 0.f;
  const int srow = tid >> 4, sdc = tid & 15;
  const int vrow = tid >> 2, vpc = tid & 3;
  const int kvb = (int)(uintptr_t)sKIv + v_rd_base(lane) + wid * 512;
  const int vvb = (int)(uintptr_t)sV + v_rd_base(lane);
#define GLA_LOAD(cc) do { const long r0 = (long)(cc) * 64;                                                           \
    _Pragma("unroll") for (int i = 0; i < 4; ++i) { rq[i] = *(const bf16x8*)(QD + (r0 + srow + 16 * i) * 512 + sdc * 8);  \
      if (MODE == 0) rk[i] = *(const bf16x8*)(KI + (r0 + srow + 16 * i) * 512 + sdc * 8); }                          \
    if (MODE == 0) rv = *(const bf16x8*)(PV + (r0 + vrow) * 2048 + vpc * 8);                                         \
    if (tid < 128) rg = GT[(long)(cc) * 512 + tid]; } while (0)
  auto chunk_of = [&](int s) { return (DIR == 0) ? (s < 4 ? 256 + s : s - 4) : 259 - s; };
  __syncthreads();
  GLA_LOAD(chunk_of(s_begin));
#pragma unroll 1
  for (int s = s_begin; s < s_end; ++s) {
    const int c = chunk_of(s);
    __syncthreads();
#pragma unroll
    for (int i = 0; i < 4; ++i) {
      const int row = srow + 16 * i;
      *(bf16x8*)(sQD + swz256(row, sdc * 16)) = rq[i];
      if (MODE == 0) {
        *(bf16x8*)(sKI + swz256(row, sdc * 16)) = rk[i];
        *(bf16x8*)(sKIv + v_st(row, sdc * 8)) = rk[i];
      }
    }
    if (MODE == 0) *(bf16x8*)(sV + v_st32(vrow, vpc * 8)) = rv;
    if (tid < 128) sG[tid] = rg;
#pragma unroll
    for (int g = 0; g < 4; ++g) {
      u32x2 w = {cvtpk(S[4 * g], S[4 * g + 1]), cvtpk(S[4 * g + 2], S[4 * g + 3])};
      *(u32x2*)(sST + r32 * 272 + (wid * 32 + 8 * g + 4 * hi) * 2) = w;
    }
    __syncthreads();
    if (s + 1 < s_end) GLA_LOAD(chunk_of(s + 1));
    if (MODE == 0) {
      const s16x4 vl0 = tr_read<0>(vvb), vh0 = tr_read<512>(vvb), vl1 = tr_read<1024>(vvb), vh1 = tr_read<1536>(vvb);
      const s16x4 vl2 = tr_read<2048>(vvb), vh2 = tr_read<2560>(vvb), vl3 = tr_read<3072>(vvb), vh3 = tr_read<3584>(vvb);
      const bf16x8 vf0 = PKF(vl0, vh0), vf1 = PKF(vl1, vh1), vf2 = PKF(vl2, vh2), vf3 = PKF(vl3, vh3);
      if (wid < 2) {
        const int ib = wid;
        f32x16 X0, X1, o;
#pragma unroll
        for (int r = 0; r < 16; ++r) { X0[r] = 0.f; X1[r] = 0.f; o[r] = 0.f; }
#pragma unroll
        for (int ks = 0; ks < 8; ++ks) {
          const int cb = (ks * 16 + hi * 8) * 2;
          const bf16x8 qf = *(const bf16x8*)(sQD + swz256(ib * 32 + r32, cb));
          const bf16x8 k0 = *(const bf16x8*)(sKI + swz256(r32, cb));
          const bf16x8 k1 = *(const bf16x8*)(sKI + swz256(32 + r32, cb));
          X0 = MFMA32(k0, qf, X0); X1 = MFMA32(k1, qf, X1);
          const bf16x8 sf = *(const bf16x8*)(sST + r32 * 272 + cb);
          o = MFMA32(qf, sf, o);
        }
        const int iq = ib * 32 + r32;
#pragma unroll
        for (int r = 0; r < 16; ++r) {
          const int j0 = crow(r, hi), j1 = 32 + j0;
          const bool v0 = (DIR == 0) ? (j0 <= iq) : (j0 >= iq);
          const bool v1 = (DIR == 0) ? (j1 <= iq) : (j1 >= iq);
          X0[r] = v0 ? X0[r] : 0.f; X1[r] = v1 ? X1[r] : 0.f;
        }
        bf16x8 pa0, pa1, pa2, pa3;
        PK4(X0, 0, pa0); PK4(X0, 8, pa1); PK4(X1, 0, pa2); PK4(X1, 8, pa3);
        o = MFMA32(pa0, vf0, o); o = MFMA32(pa1, vf1, o); o = MFMA32(pa2, vf2, o); o = MFMA32(pa3, vf3, o);
        bf16_t* od = Oo + ((long)c * 64 + ib * 32) * 32 + r32;
#pragma unroll
        for (int r = 0; r < 16; ++r) od[crow(r, hi) * 32] = f2bf(o[r]);
      }
      {
        const s16x4 al0 = tr_read<v_rd_off(0, 0, 0)>(kvb), ah0 = tr_read<v_rd_off(0, 0, 1)>(kvb), al1 = tr_read<v_rd_off(0, 1, 0)>(kvb), ah1 = tr_read<v_rd_off(0, 1, 1)>(kvb);
        const s16x4 al2 = tr_read<v_rd_off(0, 2, 0)>(kvb), ah2 = tr_read<v_rd_off(0, 2, 1)>(kvb), al3 = tr_read<v_rd_off(0, 3, 0)>(kvb), ah3 = tr_read<v_rd_off(0, 3, 1)>(kvb);
        S = MFMA32(PKF(al0, ah0), vf0, S); S = MFMA32(PKF(al1, ah1), vf1, S);
        S = MFMA32(PKF(al2, ah2), vf2, S); S = MFMA32(PKF(al3, ah3), vf3, S);
      }
    } else {
      if (wid < 2) {
        const int ib = wid;
        f32x16 o;
#pragma unroll
        for (int r = 0; r < 16; ++r) o[r] = 0.f;
#pragma unroll
        for (int ks = 0; ks < 8; ++ks) {
          const int cb = (ks * 16 + hi * 8) * 2;
          const bf16x8 qf = *(const bf16x8*)(sQD + swz256(ib * 32 + r32, cb));
          const bf16x8 sf = *(const bf16x8*)(sST + r32 * 272 + cb);
          o = MFMA32(qf, sf, o);
        }
        bf16_t* od = Oo + ((long)c * 64 + ib * 32) * 32 + r32;
#pragma unroll
        for (int r = 0; r < 16; ++r) { bf16_t* q_ = od + crow(r, hi) * 32; *q_ = f2bf(bf2f(*q_) + o[r]); }
      }
    }
#pragma unroll
    for (int r = 0; r < 16; ++r) { const float g = sG[wid * 32 + crow(r, hi)]; S[r] *= g; gacc[r] *= g; }
  }
#undef GLA_LOAD
  if (MODE == 0) {
    float* se = SE + (long)(it0 + grp) * 4096; float* gt = GTOT + (long)(it0 + grp) * 128;
#pragma unroll
    for (int r = 0; r < 16; ++r) { const int d = wid * 32 + crow(r, hi); se[d * 32 + r32] = S[r]; if (r32 == 0) gt[d] = gacc[r]; }
  }
  __syncthreads();
}

DI void glapost_item(const Params& p, int l, int it) {
  const int lane = tid_opaque() & 63, wid = tid_opaque() >> 6;
  const bf16_t* OF = (const bf16_t*)(p.ws + O_OF); const bf16_t* OB = (const bf16_t*)(p.ws + O_OB); bf16_t* PR = (bf16_t*)(p.ws + O_PR);
  const float4 wv = *(const float4*)(p.gla_norm_w + l * 256 + lane * 4);
#pragma unroll 1
  for (int rr = 0; rr < 4; ++rr) {
    const long row = (long)it * 16 + wid * 4 + rr;
#pragma unroll
    for (int h = 0; h < 4; ++h) {
      const long o = row * 1024 + h * 256 + lane * 4;
      const long os = ((long)(h * 8 + (lane >> 3)) * TB + row) * 32 + (lane & 7) * 4;
      const u32x2 a = *(const u32x2*)(OF + os), b = *(const u32x2*)(OB + os), g = *(const u32x2*)(PR + o);
      const float x0 = bflo(a[0]) + bflo(b[0]), x1 = bfhi(a[0]) + bfhi(b[0]), x2 = bflo(a[1]) + bflo(b[1]), x3 = bfhi(a[1]) + bfhi(b[1]);
      const float ss = wave_sum(x0 * x0 + x1 * x1 + x2 * x2 + x3 * x3);
      const float rinv = rsqrtf(ss * (1.f / 256.f) + EPS);
      const float g0 = bflo(g[0]), g1 = bfhi(g[0]), g2 = bflo(g[1]), g3 = bfhi(g[1]);
      const float y0 = x0 * rinv * wv.x * g0 * sigmoidf_(g0), y1 = x1 * rinv * wv.y * g1 * sigmoidf_(g1);
      const float y2 = x2 * rinv * wv.z * g2 * sigmoidf_(g2), y3 = x3 * rinv * wv.w * g3 * sigmoidf_(g3);
      u32x2 w = {cvtpk(y0, y1), cvtpk(y2, y3)};
      *(u32x2*)(PR + o) = w;
    }
  }
}

template <int D0> DI void pv_one(f32x16& od, int vb, bf16x8 pa0, bf16x8 pa1, bf16x8 pa2, bf16x8 pa3) {
  const s16x4 l0 = tr_read<v_rd_off(D0, 0, 0)>(vb), h0 = tr_read<v_rd_off(D0, 0, 1)>(vb), l1 = tr_read<v_rd_off(D0, 1, 0)>(vb), h1 = tr_read<v_rd_off(D0, 1, 1)>(vb);
  const s16x4 l2 = tr_read<v_rd_off(D0, 2, 0)>(vb), h2 = tr_read<v_rd_off(D0, 2, 1)>(vb), l3 = tr_read<v_rd_off(D0, 3, 0)>(vb), h3 = tr_read<v_rd_off(D0, 3, 1)>(vb);
#define PK(L, H) (bf16x8){L[0], L[1], L[2], L[3], H[0], H[1], H[2], H[3]}
  od = MFMA32(pa0, PK(l0, h0), od);
  od = MFMA32(pa1, PK(l1, h1), od);
  od = MFMA32(pa2, PK(l2, h2), od);
  od = MFMA32(pa3, PK(l3, h3), od);
#undef PK
}

template <int DQ, bool WINDOW>
DI void attn_item(const bf16_t* __restrict__ Q, int ldq, const bf16_t* __restrict__ Kp, int ldk, const bf16_t* __restrict__ Vp, int ldv,
                  bf16_t* __restrict__ O, int ldo, int q_row0, int a0, int a1, int b0, int b1, float scale, bool has_sink, float sink, char* lds) {
  constexpr int NQ = DQ / 16, CPR = DQ / 8, NCH = 64 * CPR / 256, KROW = DQ * 2;
  constexpr float THR = 8.f;
  const int tid = tid_opaque(), wid = tid >> 6, lane = tid & 63, r32 = lane & 31, hi = lane >> 5;
  char* V_lds = lds; char* K_lds = lds + 16384;
  float* wsf = (float*)(lds + 16384 + 64 * KROW) + wid * 64; float* li_l = wsf; float* al_l = wsf + 32;
  const float C = scale * LOG2E;
  float m_reg = -1e30f, l_reg = 0.f;
  f32x16 o[4];
#pragma unroll
  for (int d = 0; d < 4; ++d)
#pragma unroll
    for (int r = 0; r < 16; ++r) o[d][r] = 0.f;
  bf16x8 qr[NQ];
  {
    const bf16_t* Qw = Q + (long)(q_row0 + wid * 32 + r32) * ldq + hi * 8;
#pragma unroll
    for (int d0 = 0; d0 < NQ; ++d0) qr[d0] = *(const bf16x8*)(Qw + d0 * 16);
  }
  const int vsr = tid >> 4, vsc = (tid & 15) * 8;
  const int vb0 = (int)(uintptr_t)V_lds + v_rd_base(lane);
  bf16x8 sk[NCH], sv[4];
  const int na = a1 - a0, nt = na + (b1 - b0);
#define ATT_LOAD(t) do { const long kr0 = (long)(t) * 64;                                                                  \
    _Pragma("unroll") for (int i = 0; i < NCH; ++i) { const int e = tid + 256 * i; const int row = e / CPR, ch = e % CPR;   \
      sk[i] = *(const bf16x8*)(Kp + (kr0 + row) * ldk + ch * 8); }                                                         \
    _Pragma("unroll") for (int i = 0; i < 4; ++i) sv[i] = *(const bf16x8*)(Vp + (kr0 + vsr + 16 * i) * ldv + vsc); } while (0)
  ATT_LOAD(na > 0 ? a0 : b0);
  const int qpos = q_row0 + wid * 32 + r32;
#pragma unroll 1
  for (int s = 0; s < nt; ++s) {
    const int t = (s < na) ? a0 + s : b0 + (s - na);
    __syncthreads();
#pragma unroll
    for (int i = 0; i < NCH; ++i) { const int e = tid + 256 * i; const int row = e / CPR, ch = e % CPR;
      *(bf16x8*)(K_lds + row * KROW + ((ch * 16) ^ (((row >> 1) & 7) << 4))) = sk[i]; }
#pragma unroll
    for (int i = 0; i < 4; ++i) *(bf16x8*)(V_lds + v_st(vsr + 16 * i, vsc)) = sv[i];
    __syncthreads();
    if (s + 1 < nt) { const int tn = (s + 1 < na) ? a0 + s + 1 : b0 + (s + 1 - na); ATT_LOAD(tn); }
    f32x16 p0, p1;
#pragma unroll
    for (int r = 0; r < 16; ++r) { p0[r] = 0.f; p1[r] = 0.f; }
#pragma unroll
    for (int d0 = 0; d0 < NQ; ++d0) {
      const int cb = (d0 * 16 + hi * 8) * 2;
      const bf16x8 k0 = *(const bf16x8*)(K_lds + r32 * KROW + (cb ^ (((r32 >> 1) & 7) << 4)));
      const bf16x8 k1 = *(const bf16x8*)(K_lds + (32 + r32) * KROW + (cb ^ (((r32 >> 1) & 7) << 4)));
      p0 = MFMA32(k0, qr[d0], p0);
      p1 = MFMA32(k1, qr[d0], p1);
    }
    if (WINDOW && s >= na) {
      const int kbase = t * 64;
#pragma unroll
      for (int r = 0; r < 16; ++r) {
        const int k0p = kbase + crow(r, hi), k1p = k0p + 32;
        const int d0 = qpos - k0p, d1 = qpos - k1p;
        if (d0 > 128 || d0 < -128) p0[r] = -1e30f;
        if (d1 > 128 || d1 < -128) p1[r] = -1e30f;
      }
    }
    float pmax = p0[0];
#pragma unroll
    for (int r = 1; r < 16; ++r) pmax = fmaxf(pmax, p0[r]);
#pragma unroll
    for (int r = 0; r < 16; ++r) pmax = fmaxf(pmax, p1[r]);
    { auto rr = __builtin_amdgcn_permlane32_swap(__float_as_uint(pmax), __float_as_uint(pmax), false, false);
      pmax = fmaxf(__uint_as_float(rr[0]), __uint_as_float(rr[1])); }
    float mn, alpha;
    if (__all(pmax - m_reg <= THR / scale)) { mn = m_reg; alpha = 1.f; }
    else { mn = fmaxf(m_reg, pmax); alpha = __builtin_amdgcn_exp2f((m_reg - mn) * C); m_reg = mn; }
    const float mnC = -mn * C;
    float ps = 0.f;
#pragma unroll
    for (int r = 0; r < 16; ++r) { p0[r] = __builtin_amdgcn_exp2f(fmaf(p0[r], C, mnC)); ps += p0[r]; }
#pragma unroll
    for (int r = 0; r < 16; ++r) { p1[r] = __builtin_amdgcn_exp2f(fmaf(p1[r], C, mnC)); ps += p1[r]; }
    { auto rr = __builtin_amdgcn_permlane32_swap(__float_as_uint(ps), __float_as_uint(ps), false, false);
      ps = __uint_as_float(rr[0]) + __uint_as_float(rr[1]); }
    l_reg = l_reg * alpha + ps;
    bf16x8 pa0, pa1, pa2, pa3;
    PK4(p0, 0, pa0); PK4(p0, 8, pa1); PK4(p1, 0, pa2); PK4(p1, 8, pa3);
    if (__any(alpha < 1.f)) {
      if (hi == 0) al_l[r32] = alpha;
      asm volatile("s_waitcnt lgkmcnt(0)" ::: "memory");
#pragma unroll
      for (int r = 0; r < 16; ++r) { const float a = al_l[crow(r, hi)];
#pragma unroll
        for (int d = 0; d < 4; ++d) o[d][r] *= a; }
    }
    SBAR();
    pv_one<0>(o[0], vb0, pa0, pa1, pa2, pa3); pv_one<1>(o[1], vb0, pa0, pa1, pa2, pa3);
    pv_one<2>(o[2], vb0, pa0, pa1, pa2, pa3); pv_one<3>(o[3], vb0, pa0, pa1, pa2, pa3);
  }
#undef ATT_LOAD
  if (has_sink) l_reg += __builtin_amdgcn_exp2f(sink * LOG2E - m_reg * C);
  if (hi == 0) li_l[r32] = l_reg;
  asm volatile("s_waitcnt lgkmcnt(0)" ::: "memory");
  bf16_t* Ow = O + (long)(q_row0 + wid * 32) * ldo + r32;
#pragma unroll
  for (int r = 0; r < 16; ++r) {
    const int orow = crow(r, hi);
    const float rl = 1.f / li_l[orow];
#pragma unroll
    for (int d0 = 0; d0 < 4; ++d0) Ow[(long)orow * ldo + d0 * 32] = f2bf(o[d0][r] * rl);
  }
  __syncthreads();
}

constexpr int N_PHASES = 42;

struct Sched { int x, j, nj, nx; };

template <class F>
DI void for_rows(const Sched& sc, int b, bool with_ctx, int C, F f, bool cmajor = false) {
  const int nx = sc.nx;
  const int nlat = (b < 0) ? 256 : 128, nctx = with_ctx ? ((b < 0) ? 4 : 2) : 0;
  const int goff = (b < 0) ? 0 : 128 * b, coff = (b < 0) ? 256 : 256 + 2 * b;
  const int fl = ((sc.x - goff) % nx + nx) % nx;
  const int fc = ((sc.x - coff) % nx + nx) % nx;
  const int nl = (fl < nlat) ? (nlat - fl + nx - 1) / nx : 0;
  const int nc = (fc < nctx) ? (nctx - fc + nx - 1) / nx : 0;
  for (int i = sc.j; i < (nl + nc) * C; i += sc.nj) {
    int k, c;
    if (cmajor && i < nl * C) { c = i / nl; k = i - c * nl; }
    else { k = i / C; c = i - k * C; }
    const int rt = (k < nl) ? fl + k * nx : nlat + fc + (k - nl) * nx;
    f(rt, c);
  }
}

__device__ void run_phase(const Params& p, const Sched& sc, int ph, char* lds) {
  const int bid = blockIdx.x, nblk = gridDim.x;
  float* mod = (float*)(p.ws + O_MOD);
  float* Xc = (float*)(p.ws + O_XC);
  bf16_t* H = (bf16_t*)(p.ws + O_H);
  if (ph == 0) {
    const int n = DEPTH * CONV_PER_LAYER + 192 + 1;
    for (int it = bid; it < n; it += nblk) {
      if (it < DEPTH * CONV_PER_LAYER) conv_item(p, it, lds);
      else if (it < DEPTH * CONV_PER_LAYER + 192) adaln_item(p, it - DEPTH * CONV_PER_LAYER, lds);
      else rope_item(p);
    }
    return;
  }
  if (ph == N_PHASES - 1) {
    for_rows(sc, -1, false, 8, [&](int rt, int c) { finalnorm_item(p.out, p.final_norm_w, rt * 8 + c); });
    return;
  }
  const int l = (ph - 1) / 20, q = (ph - 1) % 20;
  const bool wctx = (l < DEPTH - 1);
  const float* modl = mod + (long)l * 3 * 6144;
  const bf16_t* W = (const bf16_t*)(p.ws + O_W) + (long)l * W_LAYER;
  if (q == 0) {
    const float* xl = (l == 0) ? p.x : p.out; const float* xc = (l == 0) ? p.ctx : Xc;
    for_rows(sc, -1, true, 8, [&](int rt, int c) { normmod_item(xl, xc, p.norm_mix_w + l * DM, modl, 0, 1024, H, rt * 8 + c); });
    return;
  }
  if (q >= 17) {
    if (q == 17) { for_rows(sc, -1, wctx, 8, [&](int rt, int c) { normmod_item(p.out, Xc, p.norm_mlp_w + l * DM, modl, 3072, 4096, H, rt * 8 + c); }); return; }
    if (q == 18) { for_rows(sc, -1, wctx, 32, [&](int rt, int c) { mlp1_item(p, l, rt, c, lds); }); return; }
    for_rows(sc, -1, wctx, 8, [&](int rt, int ct) {
      const long g0 = (long)rt * 128;
      float* xd = (g0 < NLAT) ? p.out + g0 * DM : Xc + (g0 - NLAT) * DM;
      const int v = (g0 < NLAT) ? (int)(g0 >> 14) : 2;
      resid_item((const bf16_t*)(p.ws + O_U) + g0 * 4096, 4096, W + W_2, 4096, modl + v * 6144 + 5120, xd, xd, ct, lds);
    });
    return;
  }
  const int b = (q - 1) / 8, s8 = (q - 1) % 8;
  if (s8 == 3) {
    for (int it = bid; it < 512; it += nblk) { const int grp = it & 7, sl = (it >> 3) & 7, dir = (it >> 6) & 1, h = it >> 7;
      if (dir) gla_body<1, 1>(p, h, sl, grp, lds); else gla_body<0, 1>(p, h, sl, grp, lds); }
    return;
  }
  const int s = (s8 < 3) ? s8 : s8 - 1;
  if (s == 0) { for_rows(sc, b, true, 42, [&](int rt, int ct) { inproj_item(p, l, b, rt, ct, lds); }); return; }
  if (s == 1) {
    for_rows(sc, b, true, 16, [&](int rt, int c) { const int ch = rt * 2 + (c >> 3), h = (c >> 1) & 3;
      if (c & 1) glaprep_body<1>(p, l, ch, h, lds); else glaprep_body<0>(p, l, ch, h, lds); });
    return;
  }
  if (s == 2) {
    const bf16_t* PS = (const bf16_t*)(p.ws + O_R2); bf16_t* OSW = (bf16_t*)(p.ws + O_OSW);
    for (int it = bid; it < 512; it += nblk) { const int grp = it & 7, sl = (it >> 3) & 7, dir = (it >> 6) & 1, h = it >> 7;
      if (dir) gla_body<1, 0>(p, h, sl, grp, lds); else gla_body<0, 0>(p, h, sl, grp, lds); }
    for_rows(sc, b, wctx, 8, [&](int qt, int h) {
      if (qt < 128) {
        const int bb0 = max(0, qt * 2 - 2), bb1 = min(256, qt * 2 + 4);
        attn_item<128, true>(PS + h * 128, 1536, PS + 1024 + (h >> 2) * 128, 1536, PS + 1280 + (h >> 2) * 128, 1536, OSW + h * 128, 1024,
                             qt * 128, 256, 260, bb0, bb1, 0.08838834764831845f, true, p.swa_sink[l * 8 + h], lds);
      } else {
        attn_item<128, false>(PS + h * 128, 1536, PS + 1024 + (h >> 2) * 128, 1536, PS + 1280 + (h >> 2) * 128, 1536, OSW + h * 128, 1024,
                              qt * 128, 256, 260, 0, 0, 0.08838834764831845f, true, p.swa_sink[l * 8 + h], lds);
      }
    });
    return;
  }
  if (s == 3) {
    for_rows(sc, b, true, 44, [&](int rt, int c) {
      if (c < 12) mlaq_item(p, l, rt, c, lds);
      else if (c < 28) mlakv_item(p, l, rt, c - 12, lds);
      else if (c < 36) glapost_item(p, l, rt * 8 + (c - 28));
      else krdup_item(p, rt * 8 + (c - 36));
    });
    return;
  }
  if (s == 4) {
    const bf16_t* Qm = (const bf16_t*)(p.ws + O_R1); const bf16_t* Km = (const bf16_t*)(p.ws + O_KM); const bf16_t* Vm = (const bf16_t*)(p.ws + O_VM);
    bf16_t* OML = (bf16_t*)(p.ws + O_R2);
    for_rows(sc, b, wctx, 8, [&](int qt, int h) {
      if (qt < 128) attn_item<192, false>(Qm + h * 192, 1536, Km + h * 192, 1536, Vm + h * 128, 1024, OML + h * 128, 1024, qt * 128, 0, 260, 0, 0, 0.07216878364870323f, false, 0.f, lds);
      else attn_item<192, false>(Qm + h * 192, 1536, Km + h * 192, 1536, Vm + h * 128, 1024, OML + h * 128, 1024, qt * 128, 256, 260, 0, 0, 0.07216878364870323f, false, 0.f, lds);
    }, true);
    return;
  }
  if (s == 5) { for_rows(sc, b, wctx, 8, [&](int rt, int ct) { merge_item(p, l, b, rt, ct, lds); }); return; }
  for_rows(sc, b, wctx, 8, [&](int rt, int ct) {
    const int lr0 = rt * 128; const long g0 = grow_of(b, lr0);
    const float* xs; float* xd;
    if (g0 < NLAT) { xs = ((l == 0) ? p.x : p.out) + g0 * DM; xd = p.out + g0 * DM; }
    else { xs = ((l == 0) ? p.ctx : Xc) + (g0 - NLAT) * DM; xd = Xc + (g0 - NLAT) * DM; }
    const int v = (g0 < NLAT) ? b : 2;
    resid_item((const bf16_t*)(p.ws + O_R1) + (long)lr0 * 1024, 1024, W + W_O, 1024, modl + v * 6144 + 2048, xs, xd, ct, lds);
  });
}

DI void grid_barrier(unsigned* ctr, unsigned target, bool heavy) {
  asm volatile("s_waitcnt vmcnt(0) lgkmcnt(0)" ::: "memory");
  __syncthreads();
  if (threadIdx.x == 0) {
    if (heavy) {
      __builtin_amdgcn_fence(__ATOMIC_RELEASE, "agent");
      asm volatile("s_waitcnt vmcnt(0) lgkmcnt(0)" ::: "memory");
    }
    __hip_atomic_fetch_add(ctr, 1u, __ATOMIC_RELAXED, __HIP_MEMORY_SCOPE_AGENT);
    while (__hip_atomic_load(ctr, __ATOMIC_RELAXED, __HIP_MEMORY_SCOPE_AGENT) < target) __builtin_amdgcn_s_sleep(1);
    __builtin_amdgcn_fence(__ATOMIC_ACQUIRE, "agent");
    asm volatile("s_waitcnt vmcnt(0) lgkmcnt(0)" ::: "memory");
  }
  __syncthreads();
}

__global__ void __launch_bounds__(256, 2) mega(Params p, int ph_lo, int ph_hi, int coop) {
  extern __shared__ __attribute__((aligned(16))) char lds[];
  unsigned* bar = (unsigned*)(p.ws + O_BAR);
  unsigned nbar = 0;
  Sched sc;
  const int xcc = (int)(__builtin_amdgcn_s_getreg((3 << 11) | 20) & 7u);
  sc.x = 0; sc.nx = 1;
  {
    int* sh = (int*)lds;
    if (threadIdx.x == 0) sh[0] = (int)__hip_atomic_fetch_add(bar + 64 + 16 * xcc, 1u, __ATOMIC_RELAXED, __HIP_MEMORY_SCOPE_AGENT);
    __syncthreads();
    sc.j = __builtin_amdgcn_readfirstlane(sh[0]);
    __syncthreads();
  }
  sc.nj = 1 << 30;
  if (coop) cg::this_grid().sync();
  {
    __builtin_amdgcn_fence(__ATOMIC_ACQUIRE, "");
    asm volatile("s_waitcnt vmcnt(0) lgkmcnt(0)" ::: "memory");
  }
  for (int ph = ph_lo; ph < ph_hi; ++ph) {
    if (ph > ph_lo && coop) {
      ++nbar;
      bool heavy = true;
      if (ph > 1) {
        const int q_ = (ph - 1) % 20;
        if (ph == N_PHASES - 1 || q_ == 0 || q_ >= 17) heavy = false;
        else { const int s_ = (q_ - 1) % 8; heavy = (s_ >= 2 && s_ <= 5); }
      }
      grid_barrier(bar, nbar * gridDim.x, heavy);
      if (ph == ph_lo + 1) {
        int nx = 0, xr = 0;
#pragma unroll
        for (int i = 0; i < 8; ++i) {
          const int cnt = (int)__hip_atomic_load(bar + 64 + 16 * i, __ATOMIC_RELAXED, __HIP_MEMORY_SCOPE_AGENT);
          if (cnt > 0) { ++nx; if (i < xcc) ++xr; }
          if (i == xcc) sc.nj = cnt;
        }
        sc.nx = __builtin_amdgcn_readfirstlane(nx); sc.x = __builtin_amdgcn_readfirstlane(xr); sc.nj = __builtin_amdgcn_readfirstlane(sc.nj);
      }
    }
    int reps_ = 1;
#ifdef PROBE_REP
    { const int q_ = (ph >= 1 && ph < N_PHASES - 1) ? (ph - 1) % 18 : -1; const int s_ = (q_ >= 1 && q_ < 15) ? (q_ - 1) % 7 : -1;
      if (PROBE_REP(q_, s_, ph)) reps_ = 2; }
#endif
#pragma unroll 1
    for (int r_ = 0; r_ < reps_; ++r_) run_phase(p, sc, ph, lds);
  }
}

extern "C" void kernel_launch(void* const* d_in, const int* in_sizes, int n_in, void* d_out, int out_size, void* d_ws, size_t ws_size,
                              hipStream_t stream) {
  static int grid_blocks = 0;
  if (!grid_blocks) {
    (void)hipFuncSetAttribute((const void*)mega, hipFuncAttributeMaxDynamicSharedMemorySize, LDS_BYTES);
    int dev = 0, cus = 0, per_cu = 0;
    (void)hipGetDevice(&dev);
    (void)hipDeviceGetAttribute(&cus, hipDeviceAttributeMultiprocessorCount, dev);
    (void)hipOccupancyMaxActiveBlocksPerMultiprocessor(&per_cu, mega, 256, LDS_BYTES);
    if (per_cu > 2) per_cu = 2;
    if (per_cu < 1) per_cu = 1;
    grid_blocks = cus * per_cu;
    if (ws_size < O_END2) fprintf(stderr, "workspace too small: %zu < %zu\n", ws_size, (size_t)O_END);
  }
  (void)hipMemsetAsync((char*)d_ws + O_BAR, 0, 1024, stream);
  Params p{};
  const float** pp = (const float**)&p;
  for (int i = 0; i < 22; ++i) pp[i] = (const float*)d_in[i];
  p.out = (float*)d_out; p.ws = (char*)d_ws;
  int lo = 0, hi = N_PHASES, coop = 1;
  void* args[] = {&p, &lo, &hi, &coop};
  hipError_t e = hipLaunchCooperativeKernel((const void*)mega, dim3(grid_blocks), dim3(256), args, LDS_BYTES, stream);
  if (e != hipSuccess) fprintf(stderr, "cooperative launch failed: %s (grid %d)\n", hipGetErrorString(e), grid_blocks);
}
```
